# Optimizing an MI355X kernel written in HIP

```python
import math
import jax, jax.numpy as jnp
from jax import lax
import numpy as np

D_MODEL = 4096
BATCH = 4
SEQ = 2048
DEPTH = 2

N_A_LAYERS = DEPTH // 2
N_B_LAYERS = DEPTH - N_A_LAYERS
ROPE_THETA = 10000.0
NORM_EPS = 1e-6
Q_BLOCK = 128
D_FF = -(-8 * D_MODEL // (3 * 256)) * 256

MLA_HEADS = D_MODEL // 128
MLA_Q_LORA = 1536
MLA_KV_LORA = 512
MLA_NOPE = 128
MLA_ROPE = 64
MLA_V = 128

NSA_HEADS = D_MODEL // 128
NSA_KV_HEADS = 4
NSA_HPG = NSA_HEADS // NSA_KV_HEADS
NSA_DK = 192
NSA_DV = 128
CMP_BLOCK = 32
CMP_STRIDE = 16
SEL_BLOCK = 64
SEL_TOPK = 16
WINDOW = 512
SEL_Q_CHUNK = 16
FORCE_BONUS = 1e4

kernel_name = "yoco_mla_nsa_hybrid"


def rms_norm(x, g):
    xf = x.astype(jnp.float32)
    y = xf * lax.rsqrt(jnp.mean(xf * xf, axis=-1, keepdims=True) + NORM_EPS)
    return (y * g.astype(jnp.float32)).astype(x.dtype)


def rope(x, pos):
    d = x.shape[-1]
    inv = ROPE_THETA ** (-jnp.arange(0, d, 2, dtype=jnp.float32) / d)
    ang = pos.astype(jnp.float32)[..., None] * inv
    ang = ang.reshape(ang.shape[:2] + (1,) * (x.ndim - 3) + (d // 2,))
    cos, sin = jnp.cos(ang), jnp.sin(ang)
    xf = x.astype(jnp.float32)
    x1, x2 = xf[..., : d // 2], xf[..., d // 2:]
    return jnp.concatenate([x1 * cos - x2 * sin, x2 * cos + x1 * sin], axis=-1).astype(x.dtype)


def masked_softmax(s, mask):
    s = jnp.where(mask, s.astype(jnp.float32), -jnp.inf)
    m = jnp.max(s, axis=-1, keepdims=True)
    m = jnp.where(jnp.isfinite(m), m, 0.0)
    e = jnp.exp(s - m)
    return e / jnp.maximum(jnp.sum(e, axis=-1, keepdims=True), 1e-30)


def swiglu(h, w_in, w_out):
    u = h @ w_in
    a, b = u[..., :D_FF], u[..., D_FF:]
    return (jax.nn.silu(a) * b) @ w_out


def causal_block_attention(q, k, v, scale):
    B, S, H, Dk = q.shape
    nb = S // Q_BLOCK
    qb = q.reshape(B, nb, Q_BLOCK, H, Dk).swapaxes(0, 1)
    kpos = jnp.arange(S)

    def step(args):
        qi, start = args
        s = jnp.einsum('bqhd,bkhd->bhqk', qi, k).astype(jnp.float32) * scale
        qpos = start + jnp.arange(Q_BLOCK)
        mask = kpos[None, :] <= qpos[:, None]
        p = masked_softmax(s, mask[None, None])
        return jnp.einsum('bhqk,bkhd->bqhd', p.astype(v.dtype), v)

    out = lax.map(step, (qb, jnp.arange(nb) * Q_BLOCK))
    return out.swapaxes(0, 1).reshape(B, S, H, v.shape[-1])


def mla_mixer(h, pos, w_in, g_q, w_uq, g_kv, w_ukv, w_o):
    B, S, _ = h.shape
    u = h @ w_in
    c_q = rms_norm(u[..., :MLA_Q_LORA], g_q)
    c_kv = rms_norm(u[..., MLA_Q_LORA:MLA_Q_LORA + MLA_KV_LORA], g_kv)
    k_rope = rope(u[..., MLA_Q_LORA + MLA_KV_LORA:][:, :, None, :], pos)
    q = (c_q @ w_uq).reshape(B, S, MLA_HEADS, MLA_NOPE + MLA_ROPE)
    q = jnp.concatenate([q[..., :MLA_NOPE], rope(q[..., MLA_NOPE:], pos)], axis=-1)
    kv = (c_kv @ w_ukv).reshape(B, S, MLA_HEADS, MLA_NOPE + MLA_V)
    k = jnp.concatenate([kv[..., :MLA_NOPE],
                         jnp.broadcast_to(k_rope, (B, S, MLA_HEADS, MLA_ROPE))], axis=-1)
    v = kv[..., MLA_NOPE:]
    o = causal_block_attention(q, k, v, (MLA_NOPE + MLA_ROPE) ** -0.5)
    return o.reshape(B, S, MLA_HEADS * MLA_V) @ w_o


def compress_blocks(t, pe, w1, w2):
    B, S, G, d = t.shape
    n_cmp = (S - CMP_BLOCK) // CMP_STRIDE + 1
    idx = (jnp.arange(n_cmp) * CMP_STRIDE)[:, None] + jnp.arange(CMP_BLOCK)[None, :]
    blocks = t[:, idx] + pe[None, None, :, None, :]
    flat = blocks.transpose(0, 1, 3, 2, 4).reshape(B, n_cmp, G, CMP_BLOCK * d)
    return jax.nn.gelu(flat @ w1) @ w2


def nsa_shared_kv(h, pos, g_s, w_kv, pe_k, w1_k, w2_k, pe_v, w1_v, w2_v):
    B, S, _ = h.shape
    u = (rms_norm(h, g_s) @ w_kv).reshape(B, S, 3, NSA_KV_HEADS, NSA_DK + NSA_DV)
    k_c, v_c = rope(u[:, :, 0, :, :NSA_DK], pos), u[:, :, 0, :, NSA_DK:]
    k_s, v_s = rope(u[:, :, 1, :, :NSA_DK], pos), u[:, :, 1, :, NSA_DK:]
    k_w, v_w = rope(u[:, :, 2, :, :NSA_DK], pos), u[:, :, 2, :, NSA_DK:]
    kc = compress_blocks(k_c, pe_k, w1_k, w2_k)
    vc = compress_blocks(v_c, pe_v, w1_v, w2_v)
    n_sel = S // SEL_BLOCK
    ks = k_s.reshape(B, n_sel, SEL_BLOCK, NSA_KV_HEADS, NSA_DK).transpose(0, 3, 1, 2, 4)
    vs = v_s.reshape(B, n_sel, SEL_BLOCK, NSA_KV_HEADS, NSA_DV).transpose(0, 3, 1, 2, 4)
    pad = ((0, 0), (WINDOW, 0), (0, 0), (0, 0))
    kw = jnp.pad(k_w, pad)
    vw = jnp.pad(v_w, pad)
    return kc, vc, ks, vs, kw, vw


def nsa_selected(q, blk_idx, blk_valid, ks, vs, scale):
    B, S, G, HPG, DK = q.shape
    nk = blk_idx.shape[-1]
    n_chunk = S // SEL_Q_CHUNK

    def chunked(a):
        return a.reshape((B, n_chunk, SEL_Q_CHUNK) + a.shape[2:]).swapaxes(0, 1)

    b_ix = jnp.arange(B)[:, None, None, None]
    g_ix = jnp.arange(G)[None, None, :, None]

    def step(args):
        qi, idx, val, start = args
        kb = ks[b_ix, g_ix, idx]
        vb = vs[b_ix, g_ix, idx]
        s = jnp.einsum('bqghd,bqgkld->bqghkl', qi, kb).astype(jnp.float32) * scale
        tok = idx[..., None] * SEL_BLOCK + jnp.arange(SEL_BLOCK)
        qpos = start + jnp.arange(SEL_Q_CHUNK)
        mask = val[..., None] & (tok <= qpos[None, :, None, None, None])
        mask = mask.reshape(B, SEL_Q_CHUNK, G, 1, nk * SEL_BLOCK)
        p = masked_softmax(s.reshape(B, SEL_Q_CHUNK, G, HPG, nk * SEL_BLOCK), mask)
        p = p.reshape(B, SEL_Q_CHUNK, G, HPG, nk, SEL_BLOCK)
        return jnp.einsum('bqghkl,bqgklv->bqghv', p.astype(vb.dtype), vb)

    out = lax.map(step, (chunked(q), chunked(blk_idx), chunked(blk_valid),
                         jnp.arange(n_chunk) * SEL_Q_CHUNK))
    return out.swapaxes(0, 1).reshape(B, S, G, HPG, vs.shape[-1])


def nsa_window(q, kw, vw, scale):
    B, S, G, HPG, DK = q.shape
    nb = S // Q_BLOCK
    span = WINDOW + Q_BLOCK
    qb = q.reshape(B, nb, Q_BLOCK, G, HPG, DK).swapaxes(0, 1)

    def step(args):
        qi, start = args
        kb = lax.dynamic_slice_in_dim(kw, start, span, axis=1)
        vb = lax.dynamic_slice_in_dim(vw, start, span, axis=1)
        s = jnp.einsum('bqghd,bkgd->bqghk', qi, kb).astype(jnp.float32) * scale
        kpos = start - WINDOW + jnp.arange(span)
        qpos = start + jnp.arange(Q_BLOCK)
        mask = ((kpos[None, :] <= qpos[:, None]) & (qpos[:, None] - kpos[None, :] < WINDOW)
                & (kpos[None, :] >= 0))
        p = masked_softmax(s, mask[None, :, None, None, :])
        return jnp.einsum('bqghk,bkgv->bqghv', p.astype(vb.dtype), vb)

    out = lax.map(step, (qb, jnp.arange(nb) * Q_BLOCK))
    return out.swapaxes(0, 1).reshape(B, S, G, HPG, vw.shape[-1])


def nsa_mixer(h, pos, shared, w_in, w_o):
    kc, vc, ks, vs, kw, vw = shared
    B, S, _ = h.shape
    G, HPG = NSA_KV_HEADS, NSA_HPG
    scale = NSA_DK ** -0.5
    u = h @ w_in
    q = rope(u[..., :NSA_HEADS * NSA_DK].reshape(B, S, G, HPG, NSA_DK), pos)
    gates = jax.nn.sigmoid(u[..., NSA_HEADS * NSA_DK:].astype(jnp.float32)).reshape(B, S, G, HPG, 3)
    t = jnp.arange(S)

    n_cmp = kc.shape[1]
    c_start = jnp.arange(n_cmp) * CMP_STRIDE
    mask_c = (c_start[None, :] + CMP_BLOCK - 1) <= t[:, None]
    s_c = jnp.einsum('bsghd,bcgd->bsghc', q, kc).astype(jnp.float32) * scale
    p_c = masked_softmax(s_c, mask_c[None, :, None, None, :])
    o_c = jnp.einsum('bsghc,bcgv->bsghv', p_c.astype(vc.dtype), vc)

    n_sel = S // SEL_BLOCK
    j_start = jnp.arange(n_sel) * SEL_BLOCK
    overlap = ((c_start[:, None] < j_start[None, :] + SEL_BLOCK)
               & (c_start[:, None] + CMP_BLOCK > j_start[None, :])).astype(jnp.float32)
    imp = jnp.einsum('bsghc,cj->bsgj', p_c, overlap)
    j = jnp.arange(n_sel)
    cur = (t // SEL_BLOCK)[:, None]
    valid = j_start[None, :] <= t[:, None]
    forced = valid & ((j[None, :] == 0) | (j[None, :] == cur) | (j[None, :] == cur - 1))
    score = jnp.where(valid[None, :, None, :],
                      imp + jnp.where(forced, FORCE_BONUS, 0.0)[None, :, None, :], -jnp.inf)
    top_vals, blk_idx = lax.top_k(score, min(SEL_TOPK, n_sel))
    blk_valid = jnp.isfinite(top_vals)
    o_s = nsa_selected(q, blk_idx, blk_valid, ks, vs, scale)

    o_w = nsa_window(q, kw, vw, scale)

    o = (gates[..., 0:1] * o_c.astype(jnp.float32) + gates[..., 1:2] * o_s.astype(jnp.float32)
         + gates[..., 2:3] * o_w.astype(jnp.float32)).astype(h.dtype)
    return o.reshape(B, S, NSA_HEADS * NSA_DV) @ w_o


def setup_inputs(seed: int = 0) -> dict:
    key = jax.random.key(seed)
    ks = jax.random.split(key, 32)

    def w(k, shape, fan_in):
        return jax.random.normal(k, shape, jnp.float32) * (fan_in ** -0.5)

    def gain(k, shape):
        return 1.0 + 0.02 * jax.random.normal(k, shape, jnp.float32)

    na, nb = N_A_LAYERS, N_B_LAYERS
    a_in_w = MLA_Q_LORA + MLA_KV_LORA + MLA_ROPE
    x = jax.random.normal(ks[0], (BATCH, SEQ, D_MODEL), jnp.float32)
    positions = (jnp.arange(SEQ, dtype=jnp.int32)[None, :]
                 + jax.random.randint(ks[1], (BATCH, 1), 0, SEQ, dtype=jnp.int32))
    return {
        "x": x,
        "positions": positions,
        "a_norm": gain(ks[2], (na, D_MODEL)),
        "a_w_in": w(ks[3], (na, D_MODEL, a_in_w), D_MODEL),
        "a_q_norm": gain(ks[4], (na, MLA_Q_LORA)),
        "a_w_uq": w(ks[5], (na, MLA_Q_LORA, MLA_HEADS * (MLA_NOPE + MLA_ROPE)), MLA_Q_LORA),
        "a_kv_norm": gain(ks[6], (na, MLA_KV_LORA)),
        "a_w_ukv": w(ks[7], (na, MLA_KV_LORA, MLA_HEADS * (MLA_NOPE + MLA_V)), MLA_KV_LORA),
        "a_w_o": w(ks[8], (na, MLA_HEADS * MLA_V, D_MODEL), MLA_HEADS * MLA_V),
        "s_norm": gain(ks[9], (D_MODEL,)),
        "s_w_kv": w(ks[10], (D_MODEL, 3 * NSA_KV_HEADS * (NSA_DK + NSA_DV)), D_MODEL),
        "s_cmp_pe_k": 0.02 * jax.random.normal(ks[11], (CMP_BLOCK, NSA_DK), jnp.float32),
        "s_cmp_w1_k": w(ks[12], (CMP_BLOCK * NSA_DK, NSA_DK), CMP_BLOCK * NSA_DK),
        "s_cmp_w2_k": w(ks[13], (NSA_DK, NSA_DK), NSA_DK),
        "s_cmp_pe_v": 0.02 * jax.random.normal(ks[14], (CMP_BLOCK, NSA_DV), jnp.float32),
        "s_cmp_w1_v": w(ks[15], (CMP_BLOCK * NSA_DV, NSA_DV), CMP_BLOCK * NSA_DV),
        "s_cmp_w2_v": w(ks[16], (NSA_DV, NSA_DV), NSA_DV),
        "b_norm": gain(ks[17], (nb, D_MODEL)),
        "b_w_in": w(ks[18], (nb, D_MODEL, NSA_HEADS * NSA_DK + 3 * NSA_HEADS), D_MODEL),
        "b_w_o": w(ks[19], (nb, NSA_HEADS * NSA_DV, D_MODEL), NSA_HEADS * NSA_DV),
        "f_norm": gain(ks[20], (DEPTH, D_MODEL)),
        "f_w_in": w(ks[21], (DEPTH, D_MODEL, 2 * D_FF), D_MODEL),
        "f_w_out": w(ks[22], (DEPTH, D_FF, D_MODEL), D_FF),
        "final_norm": gain(ks[23], (D_MODEL,)),
    }


def reference(x, positions, a_norm, a_w_in, a_q_norm, a_w_uq, a_kv_norm, a_w_ukv, a_w_o,
              s_norm, s_w_kv, s_cmp_pe_k, s_cmp_w1_k, s_cmp_w2_k, s_cmp_pe_v, s_cmp_w1_v,
              s_cmp_w2_v, b_norm, b_w_in, b_w_o, f_norm, f_w_in, f_w_out, final_norm):
    h = x
    shared = None
    for layer in range(DEPTH):
        if layer < N_A_LAYERS:
            i = layer
            h = h + mla_mixer(rms_norm(h, a_norm[i]), positions, a_w_in[i], a_q_norm[i],
                              a_w_uq[i], a_kv_norm[i], a_w_ukv[i], a_w_o[i])
        else:
            if layer == N_A_LAYERS:
                shared = nsa_shared_kv(h, positions, s_norm, s_w_kv, s_cmp_pe_k, s_cmp_w1_k,
                                       s_cmp_w2_k, s_cmp_pe_v, s_cmp_w1_v, s_cmp_w2_v)
            j = layer - N_A_LAYERS
            h = h + nsa_mixer(rms_norm(h, b_norm[j]), positions, shared, b_w_in[j], b_w_o[j])
        h = h + swiglu(rms_norm(h, f_norm[layer]), f_w_in[layer], f_w_out[layer])
    return rms_norm(h, final_norm)
```

```cpp
#include <hip/hip_runtime.h>
#include <cstdio>
#include <cstdint>
#include <cmath>
namespace pg8 {
#define PG8_LAS __attribute__((address_space(3)))
typedef unsigned short bf16_t;
typedef short bf16x8 __attribute__((ext_vector_type(8)));
typedef float f32x4 __attribute__((ext_vector_type(4)));
typedef unsigned u32x4 __attribute__((ext_vector_type(4)));
constexpr int BM = 256, BK = 64, HALF = 128, HTB = HALF * BK * 2  , STAGE_BYTES = 8 * HTB, NXCD = 8, WGM = 8;

__host__ __device__ __forceinline__ int lds_byte(int r, int c) { const int st = (r >> 4) * 2 + (c >> 5), rr = r & 15, cc = c & 31, ob = rr * 64 + cc * 2; return st * 1024 + (ob ^ (((ob >> 9) & 1) << 5)); }
__host__ __device__ __forceinline__ void stage_rc(int b, int& R, int& C) { const int st = b / 1024, sb = b % 1024, swz = sb ^ (((sb >> 9) & 1) << 5); R = (st >> 1) * 16 + swz / 64; C = (st & 1) * 32 + (swz % 64) / 2; }
__host__ __device__ __forceinline__ int perm32(int rho) { const int n = rho >> 4, i = rho & 15; return 8 * (i >> 2) + 4 * n + (i & 3); }

struct Unit { int pm, pn; };
struct Gemm { const bf16_t* A; const bf16_t* Bt; int M, N, K; };

struct StaticOrder {
    int nM, nN, nwg, G, c;
    __host__ __device__ void init(int M, int N, int G_, int c_) { nM = M / BM; nN = N / BM; nwg = nM * nN; G = G_; c = c_; }
    __host__ __device__ bool next(int i, Unit& u) const {
        const long L = (long)i * G + c; if (L >= nwg) return false;
        int wgid = (int)L; { const int q = nwg / NXCD, r = nwg % NXCD, xcd = wgid % NXCD, off = wgid / NXCD; wgid = (xcd < r ? xcd * (q + 1) : r * (q + 1) + (xcd - r) * q) + off; }
        const int nig = WGM * nN, gid = wgid / nig, fm = gid * WGM, gsz = (nM - fm) < WGM ? (nM - fm) : WGM;
        u.pm = fm + ((wgid % nig) % gsz); u.pn = (wgid % nig) / gsz; return true;
    }
    __device__ __forceinline__ void a_ready(const Unit&) const {}
    __device__ __forceinline__ void done(const Unit&) const {}
};

__device__ __forceinline__ unsigned cvt_pk_bf16(float lo, float hi) { unsigned r; asm volatile("v_cvt_pk_bf16_f32 %0, %1, %2" : "=v"(r) : "v"(lo), "v"(hi)); return r; }
template <class Epi, class Sched, bool ALIGN_EPI = false, bool SP2 = false>
__device__ __forceinline__ void gemm_phase(PG8_LAS unsigned char* lds, const Gemm g, const Sched& S, const Epi& E) {
    const int tid = threadIdx.x, wid = __builtin_amdgcn_readfirstlane(tid >> 6), lane = tid & 63, wr = wid >> 2, wc = wid & 3, fr = lane & 15, fq = lane >> 4;
    const int K = g.K, nt = K / BK;
    unsigned voffA[2], voffB[2];
#pragma unroll
    for (int i = 0; i < 2; ++i) { int R, C; stage_rc(tid * 16 + i * 8192, R, C); const int Rb = Epi::PERM ? ((R & ~31) + perm32(R & 31)) : R;
        voffA[i] = (unsigned)(R * K + C) * 2u; voffB[i] = (unsigned)(Rb * K + C) * 2u; }
    const size_t kstep = (size_t)(BK * 2);
    const size_t hstep = (size_t)HALF * K * 2;
    const size_t tstep = 2 * hstep;
    const unsigned ldsw = (unsigned)wid * 1024u;
    const int aoff = lds_byte(wr * 64 + fr, fq * 8), boff = lds_byte(wc * 32 + fr, fq * 8);
#define PG8_SA(b, h) (((b) * 2 + (h)) * HTB)
#define PG8_SB(b, h) ((4 + (b) * 2 + (h)) * HTB)
#define PG8_STAGE(bufoff, gbase, voff) do { _Pragma("unroll") for (int _i = 0; _i < 2; ++_i) \
        __builtin_amdgcn_global_load_lds((const unsigned*)((const char*)(gbase) + (voff)[_i]), (PG8_LAS unsigned*)(lds + (bufoff) + ldsw + _i * 8192), 16, 0, 0); } while (0)
#define PG8_LDA(dst, b, h) do { _Pragma("unroll") for (int m = 0; m < 4; ++m) _Pragma("unroll") for (int k = 0; k < 2; ++k) dst[m][k] = *(const PG8_LAS bf16x8*)(lds + PG8_SA(b, h) + aoff + m * 2048 + k * 1024); } while (0)
#define PG8_LDB(dst, b, h) do { _Pragma("unroll") for (int n = 0; n < 2; ++n) _Pragma("unroll") for (int k = 0; k < 2; ++k) dst[n][k] = *(const PG8_LAS bf16x8*)(lds + PG8_SB(b, h) + boff + n * 2048 + k * 1024); } while (0)
#define PG8_MMA(ai, bj, At, Bt) do { __builtin_amdgcn_s_setprio(1); _Pragma("unroll") for (int m = 0; m < 4; ++m) _Pragma("unroll") for (int n = 0; n < 2; ++n) _Pragma("unroll") for (int k = 0; k < 2; ++k) \
        acc[ai][bj][m][n] = __builtin_amdgcn_mfma_f32_16x16x32_bf16(Bt[n][k], At[m][k], acc[ai][bj][m][n], 0, 0, 0); __builtin_amdgcn_s_setprio(0); } while (0)
#define PG8_WAIT_V(n) asm volatile("s_waitcnt vmcnt(" #n ")" ::: "memory")
#define PG8_WAIT_L(n) asm volatile("s_waitcnt lgkmcnt(" #n ")" ::: "memory")
#define PG8_BAR __builtin_amdgcn_s_barrier()
#define PG8_SCHED __builtin_amdgcn_sched_barrier(0)
    Unit cur, nxt; int ui = 0;
    if (!S.next(0, cur)) return;
    f32x4 acc[2][2][4][2];
#pragma unroll
    for (int a = 0; a < 2; ++a)
#pragma unroll
        for (int b = 0; b < 2; ++b)
#pragma unroll
            for (int m = 0; m < 4; ++m)
#pragma unroll
                for (int n = 0; n < 2; ++n) acc[a][b][m][n] = (f32x4){0.f, 0.f, 0.f, 0.f};
    bf16x8 At[4][2], B0[2][2], B1[2][2];
    const char* cA = (const char*)g.A + (size_t)cur.pm * tstep; const char* cB = (const char*)g.Bt + (size_t)cur.pn * tstep;
    S.a_ready(cur);
    if constexpr (SP2) {
        PG8_STAGE(PG8_SB(0, 0), cB, voffB); PG8_STAGE(PG8_SB(0, 1), cB + hstep, voffB); PG8_STAGE(PG8_SA(0, 0), cA, voffA); PG8_STAGE(PG8_SA(0, 1), cA + hstep, voffA);
        if (wr == 1) PG8_BAR;
        PG8_WAIT_V(2); PG8_BAR;
        PG8_STAGE(PG8_SB(1, 0), cB + kstep, voffB); PG8_STAGE(PG8_SA(1, 0), cA + kstep, voffA); PG8_STAGE(PG8_SB(1, 1), cB + hstep + kstep, voffB);
        PG8_WAIT_V(6); PG8_BAR;
    } else {
        PG8_STAGE(PG8_SB(0, 0), cB, voffB); PG8_STAGE(PG8_SA(0, 0), cA, voffA); PG8_STAGE(PG8_SB(0, 1), cB + hstep, voffB); PG8_STAGE(PG8_SA(0, 1), cA + hstep, voffA);
        if (wr == 1) PG8_BAR;
        PG8_WAIT_V(4); PG8_BAR;
        PG8_STAGE(PG8_SB(1, 0), cB + kstep, voffB); PG8_STAGE(PG8_SA(1, 0), cA + kstep, voffA); PG8_STAGE(PG8_SB(1, 1), cB + hstep + kstep, voffB);
        PG8_WAIT_V(6); PG8_BAR;
    }
    for (;;) {
        const bool has_next = S.next(ui + 1, nxt);
        const char* nA = has_next ? (const char*)g.A + (size_t)nxt.pm * tstep : cA; const char* nB = has_next ? (const char*)g.Bt + (size_t)nxt.pn * tstep : cB;
        for (int t = 0; t < nt; t += 2) {
            const bool last = (t == nt - 2);
            const char* a1 = cA + (size_t)(t + 1) * kstep;
            const char* a2 = last ? nA : cA + (size_t)(t + 2) * kstep; const char* b2 = last ? nB : cB + (size_t)(t + 2) * kstep;
            const char* a3 = a2 + kstep; const char* b3 = b2 + kstep;
            if (last && has_next) S.a_ready(nxt);
            if constexpr (SP2) {
            PG8_LDB(B0, 0, 0); PG8_LDB(B1, 0, 1); PG8_SCHED; PG8_LDA(At, 0, 0); PG8_STAGE(PG8_SA(1, 1), a1 + hstep, voffA);
            PG8_WAIT_V(8); PG8_WAIT_L(0); PG8_BAR; PG8_MMA(0, 0, At, B0); PG8_MMA(0, 1, At, B1); PG8_BAR; PG8_SCHED;
            PG8_LDA(At, 0, 1); PG8_STAGE(PG8_SB(0, 0), b2, voffB); PG8_STAGE(PG8_SB(0, 1), b2 + hstep, voffB); PG8_STAGE(PG8_SA(0, 0), a2, voffA);
            PG8_WAIT_V(8); PG8_WAIT_L(0); PG8_BAR; PG8_MMA(1, 0, At, B0); PG8_MMA(1, 1, At, B1); PG8_BAR; PG8_SCHED;
            PG8_LDB(B0, 1, 0); PG8_LDB(B1, 1, 1); PG8_SCHED; PG8_LDA(At, 1, 0); PG8_STAGE(PG8_SA(0, 1), a2 + hstep, voffA);
            PG8_WAIT_V(8); PG8_WAIT_L(0); PG8_BAR; PG8_MMA(0, 0, At, B0); PG8_MMA(0, 1, At, B1); PG8_BAR; PG8_SCHED;
            PG8_LDA(At, 1, 1); PG8_STAGE(PG8_SB(1, 0), b3, voffB); PG8_STAGE(PG8_SB(1, 1), b3 + hstep, voffB); PG8_STAGE(PG8_SA(1, 0), a3, voffA);
            PG8_WAIT_V(8); PG8_WAIT_L(0); PG8_BAR; PG8_MMA(1, 0, At, B0); PG8_MMA(1, 1, At, B1); PG8_BAR; PG8_SCHED;
            } else {
            PG8_LDB(B0, 0, 0); PG8_SCHED; PG8_LDA(At, 0, 0); PG8_STAGE(PG8_SA(1, 1), a1 + hstep, voffA);
            PG8_WAIT_L(8); PG8_BAR; PG8_WAIT_L(0); PG8_MMA(0, 0, At, B0); PG8_BAR; PG8_SCHED;
            PG8_LDB(B1, 0, 1); PG8_STAGE(PG8_SB(0, 0), b2, voffB);
            PG8_BAR; PG8_WAIT_L(0); PG8_MMA(0, 1, At, B1); PG8_BAR;
            PG8_LDA(At, 0, 1); PG8_STAGE(PG8_SA(0, 0), a2, voffA);
            PG8_BAR; PG8_WAIT_L(0); PG8_MMA(1, 0, At, B0); PG8_BAR; PG8_SCHED;
            PG8_STAGE(PG8_SB(0, 1), b2 + hstep, voffB);
            PG8_WAIT_V(6); PG8_BAR; PG8_MMA(1, 1, At, B1); PG8_BAR;
            PG8_LDB(B0, 1, 0); PG8_SCHED; PG8_LDA(At, 1, 0); PG8_STAGE(PG8_SA(0, 1), a2 + hstep, voffA);
            PG8_WAIT_L(8); PG8_BAR; PG8_WAIT_L(0); PG8_MMA(0, 0, At, B0); PG8_BAR; PG8_SCHED;
            PG8_LDB(B1, 1, 1); PG8_STAGE(PG8_SB(1, 0), b3, voffB);
            PG8_BAR; PG8_WAIT_L(0); PG8_MMA(0, 1, At, B1); PG8_BAR;
            PG8_LDA(At, 1, 1); PG8_STAGE(PG8_SA(1, 0), a3, voffA);
            PG8_BAR; PG8_WAIT_L(0); PG8_MMA(1, 0, At, B0); PG8_BAR; PG8_SCHED;
            PG8_STAGE(PG8_SB(1, 1), b3 + hstep, voffB);
            PG8_WAIT_V(6); PG8_BAR; PG8_MMA(1, 1, At, B1); PG8_BAR;
            }
        }
        if constexpr (ALIGN_EPI) { if (wr == 0) PG8_BAR; }
        if constexpr (!Epi::AFTER_DRAIN) { E(acc, cur, wr, wc, fr, fq); S.done(cur); }
        if (!has_next) break;
#pragma unroll
        for (int a = 0; a < 2; ++a)
#pragma unroll
            for (int b = 0; b < 2; ++b)
#pragma unroll
                for (int m = 0; m < 4; ++m)
#pragma unroll
                    for (int n = 0; n < 2; ++n) acc[a][b][m][n] = (f32x4){0.f, 0.f, 0.f, 0.f};
        cur = nxt; cA = nA; cB = nB; ++ui;
        if constexpr (ALIGN_EPI) { if (wr == 1) PG8_BAR; }
    }
    PG8_WAIT_V(0);
    if constexpr (!ALIGN_EPI) { if (wr == 0) PG8_BAR; }
    PG8_BAR;
    if constexpr (Epi::AFTER_DRAIN) { E.fused(acc, cur, wr, wc, fr, fq, lds, wid, lane); S.done(cur); }
#undef PG8_SA
#undef PG8_SB
#undef PG8_STAGE
#undef PG8_LDA
#undef PG8_LDB
#undef PG8_MMA
#undef PG8_WAIT_V
#undef PG8_WAIT_L
#undef PG8_BAR
#undef PG8_SCHED
}
}
#define GAS __attribute__((address_space(1)))
#define LAS __attribute__((address_space(3)))
typedef unsigned short bf16;
typedef unsigned v4u __attribute__((ext_vector_type(4)));
typedef float f32x4 __attribute__((ext_vector_type(4)));
typedef short bf16x8 __attribute__((ext_vector_type(8)));
typedef GAS unsigned gu32;
typedef GAS unsigned long long gu64;
#define RLX_AGENT __ATOMIC_RELAXED, __HIP_MEMORY_SCOPE_AGENT
#define LDS_WAIT() asm volatile("s_waitcnt lgkmcnt(0)" ::: "memory")
#define VM_WAIT() asm volatile("s_waitcnt vmcnt(0)" ::: "memory")
__device__ __forceinline__ unsigned long long rt() { return __builtin_amdgcn_s_memrealtime(); }
__device__ __forceinline__ unsigned f2bf(float f) { unsigned u = __builtin_bit_cast(unsigned, f); return (u + 0x7fffu + ((u >> 16) & 1u)) >> 16; }
__device__ __forceinline__ unsigned pk2(float lo, float hi) { return f2bf(lo) | (f2bf(hi) << 16); }
#define XB_TMO      128
#define XB_XCNT(j)  (256  + 64 * (j))
#define XB_XSUB(j)  (1280 + 64 * (j))
#define XB_XGEN(j)  (2304 + 64 * (j))
#define XB_TOP      3328
#define XB_TOPGEN   3392
#define XCD_BAR_WORDS 3456
#define XB_SPIN_CAP (1u << 18)

__device__ __forceinline__ unsigned xb_ld(unsigned* p)              { return __hip_atomic_load(p, __ATOMIC_RELAXED, __HIP_MEMORY_SCOPE_AGENT); }
__device__ __forceinline__ unsigned xb_add(unsigned* p, unsigned v) { return __hip_atomic_fetch_add(p, v, __ATOMIC_RELAXED, __HIP_MEMORY_SCOPE_AGENT); }
__device__ __forceinline__ unsigned xb_xcc_id() { return (unsigned)__builtin_amdgcn_s_getreg((3 << 11) | 20) & 0xFu; }
#define XB_SPIN(cond, bar) do { unsigned _sp = 0; while (cond) { __builtin_amdgcn_s_sleep(1); \
    if ((++_sp & 255u) == 0u) { if (xb_ld(&(bar)[XB_TMO])) break; if (_sp > XB_SPIN_CAP) { atomicAdd(&(bar)[XB_TMO], 1u); break; } } } } while (0)

struct XcdBarrier {
    unsigned* bar; unsigned x;
    volatile LAS unsigned* st;
};

__device__ __forceinline__ XcdBarrier xcd_barrier_post(unsigned* bar, volatile LAS unsigned* st) {
    XcdBarrier b; b.bar = bar; b.x = xb_xcc_id(); b.st = st;
    if (threadIdx.x == 0) (void)xb_add(&bar[XB_XCNT(b.x)], 1u);
    return b;
}
__device__ __forceinline__ void xcd_barrier_complete(unsigned* bar, unsigned x, unsigned& nloc, unsigned& nx) {
    const unsigned G = gridDim.x * gridDim.y * gridDim.z;
    unsigned sum, cnt, mine, sp = 0u;
    for (;;) {
        sum = 0u; cnt = 0u; mine = 0u;
#pragma unroll
        for (unsigned j = 0; j < 16; ++j) { const unsigned c = xb_ld(&bar[XB_XCNT(j)]); sum += c; cnt += (c > 0u) ? 1u : 0u; mine = (j == x) ? c : mine; }
        if (sum == G) break;
        __builtin_amdgcn_s_sleep(1);
        if ((++sp & 255u) == 0u) { if (xb_ld(&bar[XB_TMO])) break; if (sp > XB_SPIN_CAP) { atomicAdd(&bar[XB_TMO], 1u); break; } }
    }
    nloc = mine > 0u ? mine : 1u; nx = cnt > 0u ? cnt : 1u;
}

__device__ __forceinline__ void xcd_barrier(const XcdBarrier& b) {
    asm volatile("s_waitcnt vmcnt(0)" ::: "memory");
    __syncthreads();
    if (threadIdx.x == 0) {
        unsigned* bar = b.bar;
        __builtin_amdgcn_s_waitcnt(0);
        unsigned nloc = b.st[0], nx = b.st[1];
        if (nloc == 0u) { xcd_barrier_complete(bar, b.x, nloc, nx); b.st[0] = nloc; b.st[1] = nx; }
        const unsigned old = xb_add(&bar[XB_XSUB(b.x)], 1u);
        const unsigned gen = old / nloc;
        if (old + 1u == (gen + 1u) * nloc) {
            __builtin_amdgcn_fence(__ATOMIC_RELEASE, "agent");
            asm volatile("s_waitcnt vmcnt(0)" ::: "memory");
            const unsigned og = xb_add(&bar[XB_TOP], 1u);
            const unsigned tg = og / nx;
            if (og + 1u == (tg + 1u) * nx) xb_add(&bar[XB_TOPGEN], 1u);
            else XB_SPIN(xb_ld(&bar[XB_TOPGEN]) == tg, bar);
            __builtin_amdgcn_fence(__ATOMIC_ACQUIRE, "agent");
            xb_add(&bar[XB_XGEN(b.x)], 1u);
            asm volatile("s_waitcnt vmcnt(0)" ::: "memory");
        } else {
            XB_SPIN(xb_ld(&bar[XB_XGEN(b.x)]) == gen, bar);
            __builtin_amdgcn_fence(__ATOMIC_ACQUIRE, "agent");
            asm volatile("s_waitcnt vmcnt(0)" ::: "memory");
        }
    }
    __syncthreads();
}
constexpr int NB = 4, SEQ = 2048, M = NB * SEQ, DM = 4096, FF = 11008;
constexpr int QL = 1536, KVL = 512, A_IN = 2112, A_IN_PAD = 2304;
constexpr int MH = 32, DQK = 192, DVV = 128;
constexpr int UQ_N = MH * DQK;
constexpr int UKV_N = MH * 256;
constexpr int NG = 4, HPG = 8, NH = 32;
constexpr int SB_N = 10240;
constexpr int SB_K0 = 0, SB_V0 = 2304, SB_Q0 = 3840, SB_G0 = 9984;
constexpr int NCMP_PAD = 128;
constexpr float NORM_EPS = 1e-6f;
constexpr float QSCALE = 0.07216878364870322f * 1.4426950408889634f;
constexpr int NWAVES = 8;
#ifndef MK_ONE_LAUNCH
#define MK_ONE_LAUNCH 0
#endif

constexpr size_t MiB = 1u << 20;
constexpr size_t alignup(size_t x) { return (x + (MiB - 1)) & ~(MiB - 1); }
constexpr size_t WS_CTL = 0, CTL_ZERO_BYTES = 1 * MiB;
constexpr size_t WS_WA   = 1 * MiB;
constexpr size_t WS_WUQ  = WS_WA   + alignup((size_t)A_IN_PAD * DM * 2);
constexpr size_t WS_WUKV = WS_WUQ  + alignup((size_t)UQ_N * QL * 2);
constexpr size_t WS_WOA  = WS_WUKV + alignup((size_t)UKV_N * KVL * 2);
constexpr size_t WS_WFI  = WS_WOA  + alignup((size_t)DM * DM * 2);
constexpr size_t WFI_STRIDE = alignup((size_t)2 * FF * DM * 2);
constexpr size_t WS_WFO  = WS_WFI  + 2 * WFI_STRIDE;
constexpr size_t WFO_STRIDE = alignup((size_t)DM * FF * 2);
constexpr size_t WS_WSB  = WS_WFO  + 2 * WFO_STRIDE;
constexpr size_t WS_WOB  = WS_WSB  + alignup((size_t)SB_N * DM * 2);
constexpr size_t WS_W1K  = WS_WOB  + alignup((size_t)DM * DM * 2);
constexpr size_t WS_W2K  = WS_W1K  + alignup((size_t)192 * 6144 * 2);
constexpr size_t WS_W1V  = WS_W2K  + MiB;
constexpr size_t WS_W2V  = WS_W1V  + alignup((size_t)128 * 4096 * 2);
constexpr size_t WS_BIAS = WS_W2V  + MiB;
constexpr size_t WS_TABA = WS_BIAS + MiB;
constexpr size_t WS_TABB = WS_TABA + alignup((size_t)M * 32 * 8);
constexpr size_t WS_XN   = WS_TABB + alignup((size_t)M * 96 * 8);
constexpr size_t WS_UA   = WS_XN   + alignup((size_t)M * DM * 2);
constexpr size_t WS_CQ   = WS_UA   + alignup((size_t)M * A_IN_PAD * 4);
constexpr size_t WS_CKV  = WS_CQ   + alignup((size_t)M * QL * 2);
constexpr size_t WS_QA   = WS_CKV  + alignup((size_t)M * KVL * 2);
constexpr size_t WS_KA   = WS_QA   + alignup((size_t)M * UQ_N * 2);
constexpr size_t WS_VA   = WS_KA   + alignup((size_t)M * MH * DQK * 2);
constexpr size_t WS_OA   = WS_VA   + alignup((size_t)M * MH * DVV * 2);
constexpr size_t WS_H    = WS_OA   + alignup((size_t)M * DM * 2);
constexpr size_t WS_ACT  = WS_H    + alignup((size_t)M * DM * 4);
constexpr size_t WS_KB   = WS_ACT  + alignup((size_t)M * FF * 2);
constexpr size_t KB_BR   = (size_t)NB * NG * SEQ * DQK;
constexpr size_t WS_VB   = WS_KB   + alignup(3 * KB_BR * 2 + MiB);
constexpr size_t VB_BR   = (size_t)NB * NG * SEQ * DVV;
constexpr size_t WS_GATE = WS_VB   + alignup(3 * VB_BR * 2 + MiB);
constexpr size_t WS_HIDK = WS_GATE + alignup((size_t)M * 96 * 4);
constexpr size_t WS_HIDV = WS_HIDK + MiB;
constexpr size_t WS_KC   = WS_HIDV + MiB;
constexpr size_t WS_VC   = WS_KC   + MiB;
constexpr size_t WS_SEL  = WS_VC   + MiB;
constexpr size_t WS_OC   = WS_SEL  + MiB;
constexpr size_t WS_OS   = WS_OC   + alignup((size_t)M * DM * 4);
constexpr size_t WS_END  = WS_OS   + alignup((size_t)M * DM * 4);

constexpr int CW_TMO = 0, CW_CODE = 1, CW_BAR = 4096;

constexpr int RING_OFF = 0, RING_BYTES = 131072;
constexpr int LDSCTL_OFF = RING_BYTES, MISC_OFF = LDSCTL_OFF + 320;
constexpr int LDS_BYTES = 147456;
constexpr int ATT_K = 0, ATT_K2 = 24576, ATT_V = 49152, ATT_WS = 81920, ATT_IMP = 83968, ATT_SC = 116736, ATT_SELW = 120832;
typedef float f32x16 __attribute__((ext_vector_type(16)));
typedef float f32x2 __attribute__((ext_vector_type(2)));
typedef short s16x4 __attribute__((ext_vector_type(4)));
typedef unsigned long long u64;

__device__ __forceinline__ unsigned cvtpk(float lo, float hi) { unsigned r; asm volatile("v_cvt_pk_bf16_f32 %0, %1, %2" : "=v"(r) : "v"(lo), "v"(hi)); return r; }
__device__ __forceinline__ v4u pk8(f32x4 a, f32x4 b) { v4u w; w.x = cvtpk(a[0], a[1]); w.y = cvtpk(a[2], a[3]); w.z = cvtpk(b[0], b[1]); w.w = cvtpk(b[2], b[3]); return w; }
__device__ __forceinline__ float wave_sum(float v) {
#pragma unroll
    for (int o = 1; o < 64; o <<= 1) v += __shfl_xor(v, o);
    return v;
}
__device__ __forceinline__ float bf2f(bf16 b) { return __builtin_bit_cast(float, (unsigned)b << 16); }
__device__ __forceinline__ float fast_exp2(float x) { return __builtin_amdgcn_exp2f(x); }
__device__ __forceinline__ float sigmoidf_(float x) { return 1.f / (1.f + __expf(-x)); }
__device__ __forceinline__ float gelu_tanh(float x) { const float z = 0.7978845608028654f * (x + 0.044715f * x * x * x); return x / (1.f + __expf(-2.f * z)); }
__device__ __forceinline__ int crow(int r, int hi) { return (r & 3) + 8 * (r >> 2) + 4 * hi; }
#define SBAR() __builtin_amdgcn_sched_barrier(0)

struct Frame {
    LAS unsigned char* lds;
    volatile LAS unsigned* MISC;
    gu32* ctl;
    int tid, lane, wave;
    int vcu, G;
    unsigned char* ws;
};

template <class CM, class RM>
__device__ __forceinline__ void conv_item(const float* __restrict__ W, int Nsrc, const float* __restrict__ gain, bf16* WT, int K, int row_off, int nblk, LAS float* scr, int item, int lane, const CM& cm, const RM& rm) {
    const int kb = item / nblk, nb = item - kb * nblk, k0 = 64 * kb, n0 = 32 * nb;
    const int sc = cm(n0 + (lane & 31));
#pragma unroll 8
    for (int i = 0; i < 32; ++i) { const int kk = 2 * i + (lane >> 5); const int sr = rm(k0 + kk);
        float v = 0.f; if (sc >= 0) { v = W[(size_t)sr * Nsrc + sc]; if (gain) v *= gain[sr]; }
        scr[kk * 33 + (lane & 31)] = v; }
    LDS_WAIT(); asm volatile("" ::: "memory");
    const int c = lane & 7;
#pragma unroll
    for (int j = 0; j < 4; ++j) { const int n = (lane >> 3) + 8 * j; const LAS float* s = scr + (8 * c) * 33 + n;
        v4u o; o.x = pk2(s[0 * 33], s[1 * 33]); o.y = pk2(s[2 * 33], s[3 * 33]); o.z = pk2(s[4 * 33], s[5 * 33]); o.w = pk2(s[6 * 33], s[7 * 33]);
        *(GAS v4u*)(WT + (size_t)(row_off + n0 + n) * K + k0 + 8 * c) = o; }
    LDS_WAIT(); asm volatile("" ::: "memory");
}
template <class CM, class RM>
__device__ __forceinline__ void conv_matrix(Frame& F, const float* W, int Nsrc, const float* gain, bf16* WT, int K, int Ndst, int row_off, const CM& cm, const RM& rm) {
    LAS float* scr = (LAS float*)(F.lds + RING_OFF + F.wave * 16384);
    const int gw = F.vcu * NWAVES + F.wave, NGW = F.G * NWAVES;
    const int nblk = Ndst / 32, nitems = (K / 64) * nblk;
    for (int it = gw; it < nitems; it += NGW) conv_item(W, Nsrc, gain, WT, K, row_off, nblk, scr, it, F.lane, cm, rm);
}
struct MapId { __device__ __forceinline__ int operator()(int n) const { return n; } };
struct MapLim { int lim; __device__ __forceinline__ int operator()(int n) const { return n < lim ? n : -1; } };
struct MapUq { __device__ __forceinline__ int operator()(int n) const { const int h = n / 192, dp = n - h * 192; const int d = dp < 128 ? dp : 128 + ((dp - 128) >> 1) + 32 * ((dp - 128) & 1); return h * 192 + d; } };
struct MapFfi { __device__ __forceinline__ int operator()(int n) const { const int t = n >> 8, p = (n >> 7) & 1, j = n & 127; return p * FF + 128 * t + j; } };
__device__ __forceinline__ int nsa_d(int dp) { return (dp >> 1) + 96 * (dp & 1); }
struct MapSkv { __device__ __forceinline__ int operator()(int n) const {
        if (n < SB_V0) { const int kh = n / 192, dp = n - kh * 192; return kh * 320 + nsa_d(dp); }
        const int c2 = n - SB_V0, kh = c2 >> 7, dv = c2 & 127; return kh * 320 + 192 + dv; } };
struct MapBin { __device__ __forceinline__ int operator()(int n) const {
        if (n < 6144) { const int h = n / 192, dp = n - h * 192; return h * 192 + nsa_d(dp); }
        return n < 6240 ? n : -1; } };
struct MapW1kRow { __device__ __forceinline__ int operator()(int k) const { const int l = k / 192, dp = k - l * 192; return l * 192 + nsa_d(dp); } };
struct MapW2kCol { __device__ __forceinline__ int operator()(int n) const { return nsa_d(n); } };

__device__ __forceinline__ u64 pack4(f32x4 v) { return (u64)cvtpk(v[0], v[1]) | ((u64)cvtpk(v[2], v[3]) << 32); }
__device__ __forceinline__ void norm_row_bf16(const float* xrow, bf16* orow, int lane) {
    const GAS f32x4* xr = (const GAS f32x4*)xrow + lane;
    f32x4 v[16]; float s = 0.f;
#pragma unroll
    for (int j = 0; j < 16; ++j) { v[j] = xr[64 * j]; s += (v[j].x * v[j].x + v[j].y * v[j].y) + (v[j].z * v[j].z + v[j].w * v[j].w); }
    const float r = 1.f / sqrtf(wave_sum(s) * (1.f / DM) + NORM_EPS);
    GAS u64* o8 = (GAS u64*)orow + lane;
#pragma unroll
    for (int j = 0; j < 16; ++j) o8[64 * j] = pack4(v[j] * r);
}
__device__ __forceinline__ void norm_phase(Frame& F, const float* X, bf16* XN) {
    const int gw = F.vcu * NWAVES + F.wave, NGW = F.G * NWAVES;
    for (int m = gw; m < M; m += NGW) norm_row_bf16(X + (size_t)m * DM, XN + (size_t)m * DM, F.lane);
}
__device__ __forceinline__ void final_norm_phase(Frame& F, const float* X, const float* g, float* out) {
    const int gw = F.vcu * NWAVES + F.wave, NGW = F.G * NWAVES;
    for (int m = gw; m < M; m += NGW) {
        const GAS f32x4* xr = (const GAS f32x4*)(X + (size_t)m * DM) + F.lane; const GAS f32x4* gr = (const GAS f32x4*)g + F.lane;
        f32x4 v[16]; float s = 0.f;
#pragma unroll
        for (int j = 0; j < 16; ++j) { v[j] = xr[64 * j]; s += (v[j].x * v[j].x + v[j].y * v[j].y) + (v[j].z * v[j].z + v[j].w * v[j].w); }
        const float r = 1.f / sqrtf(wave_sum(s) * (1.f / DM) + NORM_EPS);
        GAS f32x4* o = (GAS f32x4*)(out + (size_t)m * DM) + F.lane;
#pragma unroll
        for (int j = 0; j < 16; ++j) o[64 * j] = v[j] * r * gr[64 * j];
    }
}
__device__ __forceinline__ void rope_tables(Frame& F, const int* pos, f32x2* tabA, f32x2* tabB) {
    const int gt = F.vcu * NWAVES * 64 + F.tid, NT = F.G * NWAVES * 64;
    for (int e = gt; e < M * 128; e += NT) {
        const int tok = e >> 7, j = e & 127;
        const bool isA = j < 32; const int i = isA ? j : j - 32; const float d = isA ? 64.f : 192.f;
        const float inv = powf(10000.f, -(float)(2 * i) / d);
        const float ang = (float)pos[tok] * inv;
        const double rev = (double)ang * 0.15915494309189535; const float fr = (float)(rev - floor(rev));
        f32x2 cs; cs.x = __builtin_amdgcn_cosf(fr); cs.y = __builtin_amdgcn_sinf(fr);
        if (isA) tabA[(size_t)tok * 32 + i] = cs; else tabB[(size_t)tok * 96 + i] = cs;
    }
}
__device__ __forceinline__ void pe_bias(Frame& F, const float* pe, const float* W1, int K, int N, float* bias) {
    const int gw = F.vcu * NWAVES + F.wave, NGW = F.G * NWAVES;
    for (int n = gw; n < N; n += NGW) { float s = 0.f; for (int k = F.lane; k < K; k += 64) s += pe[k] * W1[(size_t)k * N + n]; s = wave_sum(s); if (F.lane == 0) bias[n] = s; }
}
__device__ __forceinline__ void mla_latent_phase(Frame& F, const float* UA, bf16* CQ, bf16* CKV, bf16* KA, const f32x2* tabA) {
    const int gw = F.vcu * NWAVES + F.wave, NGW = F.G * NWAVES; const int lane = F.lane;
    for (int m = gw; m < M; m += NGW) {
        const float* u = UA + (size_t)m * A_IN_PAD;
        const GAS f32x4* uq = (const GAS f32x4*)u + lane; f32x4 q[6]; float s = 0.f;
#pragma unroll
        for (int j = 0; j < 6; ++j) { q[j] = uq[64 * j]; s += (q[j].x * q[j].x + q[j].y * q[j].y) + (q[j].z * q[j].z + q[j].w * q[j].w); }
        const float rq = 1.f / sqrtf(wave_sum(s) * (1.f / QL) + NORM_EPS);
        GAS u64* oq = (GAS u64*)(CQ + (size_t)m * QL) + lane;
#pragma unroll
        for (int j = 0; j < 6; ++j) oq[64 * j] = pack4(q[j] * rq);
        const GAS f32x4* uk = (const GAS f32x4*)(u + QL) + lane; f32x4 kv[2]; float s2 = 0.f;
#pragma unroll
        for (int j = 0; j < 2; ++j) { kv[j] = uk[64 * j]; s2 += (kv[j].x * kv[j].x + kv[j].y * kv[j].y) + (kv[j].z * kv[j].z + kv[j].w * kv[j].w); }
        const float rk = 1.f / sqrtf(wave_sum(s2) * (1.f / KVL) + NORM_EPS);
        GAS u64* ok = (GAS u64*)(CKV + (size_t)m * KVL) + lane;
#pragma unroll
        for (int j = 0; j < 2; ++j) ok[64 * j] = pack4(kv[j] * rk);
        const int i = lane & 31; const float x1 = u[QL + KVL + i], x2 = u[QL + KVL + 32 + i]; const f32x2 cs = tabA[(size_t)m * 32 + i];
        const unsigned pk = cvtpk(x1 * cs.x - x2 * cs.y, x2 * cs.x + x1 * cs.y);
        const int b = m >> 11, sq = m & 2047, h0 = (lane >> 5) * 16;
#pragma unroll 4
        for (int h = 0; h < 16; ++h) *(GAS unsigned*)(KA + ((size_t)((b * MH + h0 + h) * SEQ + sq)) * DQK + 128 + 2 * i) = pk;
    }
}
template <class Fn> struct EpiRow8 {
    static constexpr bool PERM = true, AFTER_DRAIN = false; Fn f;
    __device__ __forceinline__ void operator()(const pg8::f32x4 (&acc)[2][2][4][2], const pg8::Unit& u, int wr, int wc, int fr, int fq) const {
        const int row0 = u.pm * 256 + wr * 64 + fr, col0 = u.pn * 256 + wc * 32 + 8 * fq;
#pragma unroll
        for (int ai = 0; ai < 2; ++ai)
#pragma unroll
            for (int m = 0; m < 4; ++m)
#pragma unroll
                for (int bj = 0; bj < 2; ++bj) f(row0 + ai * 128 + m * 16, col0 + bj * 128, acc[ai][bj][m][0], acc[ai][bj][m][1]);
    }
};
template <class Fn> struct EpiGate {
    static constexpr bool PERM = true, AFTER_DRAIN = false; Fn f;
    __device__ __forceinline__ void operator()(const pg8::f32x4 (&acc)[2][2][4][2], const pg8::Unit& u, int wr, int wc, int fr, int fq) const {
        const int row0 = u.pm * 256 + wr * 64 + fr, col0 = u.pn * 128 + wc * 32 + 8 * fq;
#pragma unroll
        for (int ai = 0; ai < 2; ++ai)
#pragma unroll
            for (int m = 0; m < 4; ++m) f(row0 + ai * 128 + m * 16, col0, acc[ai][0][m][0], acc[ai][0][m][1], acc[ai][1][m][0], acc[ai][1][m][1]);
    }
};
__device__ __forceinline__ void rope4(f32x4& v0, f32x4& v1, const f32x2* t) {
    const f32x4 t0 = *(const GAS f32x4*)t, t1 = *(const GAS f32x4*)(t + 2);
    f32x4 a, b;
    a.x = v0.x * t0.x - v0.y * t0.y; a.y = v0.y * t0.x + v0.x * t0.y; a.z = v0.z * t0.z - v0.w * t0.w; a.w = v0.w * t0.z + v0.z * t0.w;
    b.x = v1.x * t1.x - v1.y * t1.y; b.y = v1.y * t1.x + v1.x * t1.y; b.z = v1.z * t1.z - v1.w * t1.w; b.w = v1.w * t1.z + v1.z * t1.w;
    v0 = a; v1 = b;
}
#define GOFF(T, base, byteoff) (*(GAS T*)((GAS char*)(base) + (byteoff)))
struct FnUA { float* UA; __device__ __forceinline__ void operator()(int row, int col, f32x4 v0, f32x4 v1) const {
        if (col < A_IN) { const unsigned o = ((unsigned)row * A_IN_PAD + col) * 4u; GOFF(f32x4, UA, o) = v0; GOFF(f32x4, UA, o + 16u) = v1; } } };
struct FnQa { bf16* QA; const f32x2* tab; __device__ __forceinline__ void operator()(int row, int col, f32x4 v0, f32x4 v1) const {
        const int h = col / 192, d = col - h * 192;
        if (d >= 128) { const unsigned to = ((unsigned)row * 32 + ((d - 128) >> 1)) * 8u; rope4(v0, v1, (const f32x2*)((const GAS char*)tab + to)); }
        GOFF(v4u, QA, ((unsigned)row * UQ_N + col) * 2u) = pk8(v0 * QSCALE, v1 * QSCALE); } };
struct FnKVa { bf16* KA; bf16* VA; __device__ __forceinline__ void operator()(int row, int col, f32x4 v0, f32x4 v1) const {
        const int h = col >> 8, j = col & 255, b = row >> 11, s = row & 2047; const unsigned r = (unsigned)(b * MH + h) * SEQ + s;
        if (j < 128) GOFF(v4u, KA, (r * DQK + j) * 2u) = pk8(v0, v1); else GOFF(v4u, VA, (r * DVV + (j - 128)) * 2u) = pk8(v0, v1); } };
struct FnResNew { const float* X; float* H; __device__ __forceinline__ void operator()(int row, int col, f32x4 v0, f32x4 v1) const {
        const unsigned o = ((unsigned)row * DM + col) * 4u; const f32x4 x0 = GOFF(const f32x4, X, o), x1 = GOFF(const f32x4, X, o + 16u);
        GOFF(f32x4, H, o) = x0 + v0; GOFF(f32x4, H, o + 16u) = x1 + v1; } };
struct FnResAcc { float* H; __device__ __forceinline__ void operator()(int row, int col, f32x4 v0, f32x4 v1) const {
        const unsigned o = ((unsigned)row * DM + col) * 4u; const f32x4 x0 = GOFF(const f32x4, H, o), x1 = GOFF(const f32x4, H, o + 16u);
        GOFF(f32x4, H, o) = x0 + v0; GOFF(f32x4, H, o + 16u) = x1 + v1; } };
__device__ __forceinline__ float swiglu1(float a, float b) { return a * b / (1.f + __expf(-a)); }
struct FnSwiglu { bf16* ACT; __device__ __forceinline__ void operator()(int row, int col, f32x4 a0, f32x4 a1, f32x4 b0, f32x4 b1) const {
        f32x4 r0, r1;
#pragma unroll
        for (int i = 0; i < 4; ++i) { r0[i] = swiglu1(a0[i], b0[i]); r1[i] = swiglu1(a1[i], b1[i]); }
        GOFF(v4u, ACT, ((unsigned)row * FF + col) * 2u) = pk8(r0, r1); } };
struct EpiSB {
    static constexpr bool PERM = true, AFTER_DRAIN = false;
    bf16* KB; bf16* VB; bf16* QB; float* GATE; const f32x2* tab;
    __device__ __forceinline__ void operator()(const pg8::f32x4 (&acc)[2][2][4][2], const pg8::Unit& u, int wr, int wc, int fr, int fq) const {
        const int row0 = u.pm * 256 + wr * 64 + fr, cl = wc * 32 + 8 * fq;
        const int b = row0 >> 11, s0 = row0 & 2047;
        if (u.pn < 9) {
#pragma unroll
            for (int bj = 0; bj < 2; ++bj) { const int col = u.pn * 256 + bj * 128 + cl, kh = col / 192, dp = col - kh * 192, br = kh >> 2, g = kh & 3;
                const unsigned ob = ((unsigned)br * (unsigned)KB_BR + ((unsigned)((b * NG + g) * SEQ + s0)) * DQK + dp) * 2u, tb = ((unsigned)row0 * 96 + (dp >> 1)) * 8u;
#pragma unroll
                for (int ai = 0; ai < 2; ++ai)
#pragma unroll
                    for (int m = 0; m < 4; ++m) { const unsigned ro = ai * 128 + m * 16; f32x4 v0 = acc[ai][bj][m][0], v1 = acc[ai][bj][m][1];
                        rope4(v0, v1, (const f32x2*)((const GAS char*)tab + tb + ro * 768u)); GOFF(v4u, KB, ob + ro * (DQK * 2u)) = pk8(v0, v1); } }
        } else if (u.pn < 15) {
#pragma unroll
            for (int bj = 0; bj < 2; ++bj) { const int c2 = (u.pn - 9) * 256 + bj * 128 + cl, kh = c2 >> 7, dv = c2 & 127, br = kh >> 2, g = kh & 3;
                const unsigned ob = ((unsigned)br * (unsigned)VB_BR + ((unsigned)((b * NG + g) * SEQ + s0)) * DVV + dv) * 2u;
#pragma unroll
                for (int ai = 0; ai < 2; ++ai)
#pragma unroll
                    for (int m = 0; m < 4; ++m) { const unsigned ro = ai * 128 + m * 16; GOFF(v4u, VB, ob + ro * (DVV * 2u)) = pk8(acc[ai][bj][m][0], acc[ai][bj][m][1]); } }
        } else if (u.pn < 39) {
#pragma unroll
            for (int bj = 0; bj < 2; ++bj) { const int c3 = (u.pn - 15) * 256 + bj * 128 + cl, h = c3 / 192, dp = c3 - h * 192;
                const unsigned ob = ((unsigned)row0 * UQ_N + c3) * 2u, tb = ((unsigned)row0 * 96 + (dp >> 1)) * 8u;
#pragma unroll
                for (int ai = 0; ai < 2; ++ai)
#pragma unroll
                    for (int m = 0; m < 4; ++m) { const unsigned ro = ai * 128 + m * 16; f32x4 v0 = acc[ai][bj][m][0], v1 = acc[ai][bj][m][1];
                        rope4(v0, v1, (const f32x2*)((const GAS char*)tab + tb + ro * 768u)); GOFF(v4u, QB, ob + ro * (UQ_N * 2u)) = pk8(v0 * QSCALE, v1 * QSCALE); } }
        } else {
            if (cl < 96) {
                const unsigned ob = ((unsigned)row0 * 96 + cl) * 4u;
#pragma unroll
                for (int ai = 0; ai < 2; ++ai)
#pragma unroll
                    for (int m = 0; m < 4; ++m) { const unsigned ro = ai * 128 + m * 16; f32x4 g0, g1;
#pragma unroll
                        for (int i = 0; i < 4; ++i) { g0[i] = sigmoidf_(acc[ai][0][m][0][i]); g1[i] = sigmoidf_(acc[ai][0][m][1][i]); }
                        GOFF(f32x4, GATE, ob + ro * 384u) = g0; GOFF(f32x4, GATE, ob + ro * 384u + 16u) = g1; }
            }
        }
    }
};
__device__ __forceinline__ int v_st(int k, int c) { const int kk = (k & ~0xC) | ((k & 4) << 1) | ((k & 8) >> 1); return ((kk >> 3) * 4 + (c >> 5)) * 512 + ((kk & 7) * 32 + (c & 31)) * 2; }
__device__ __forceinline__ int v_rd_base(int lane) { return ((lane & 3) << 3) | (((lane >> 2) & 3) << 6) | (((lane >> 4) & 1) << 5) | (((lane >> 5) & 1) << 8); }
constexpr int v_rd_off(int d0, int ks, int half) { return d0 * 512 + ks * 4096 + half * 2048; }

__device__ __forceinline__ void stage_kv(LAS unsigned char* L, int koff, int voff, const bf16* __restrict__ Kg, const bf16* __restrict__ Vg, int tid) {
    v4u kr[3], vr[2];
    const GAS char* kg = (const GAS char*)Kg; const GAS char* vg = (const GAS char*)Vg;
#pragma unroll
    for (int i = 0; i < 3; ++i) { const unsigned id = (unsigned)tid + 512u * i; kr[i] = *(const GAS v4u*)(kg + id * 16u); }
    const unsigned sr = (unsigned)tid >> 4, sc = ((unsigned)tid & 15u) * 8u;
    vr[0] = *(const GAS v4u*)(vg + (unsigned)tid * 16u); vr[1] = *(const GAS v4u*)(vg + (unsigned)tid * 16u + 8192u);
#pragma unroll
    for (int i = 0; i < 3; ++i) { const int id = tid + 512 * i, key = id / 24, c24 = id - key * 24, s = c24 >> 3, c = c24 & 7;
        *(LAS v4u*)(L + koff + s * 8192 + key * 128 + ((c ^ ((key >> 1) & 7)) << 4)) = kr[i]; }
    *(LAS v4u*)(L + voff + v_st(sr, sc)) = vr[0]; *(LAS v4u*)(L + voff + v_st(32 + sr, sc)) = vr[1];
}
__device__ __forceinline__ void qkt(f32x16& p0, f32x16& p1, LAS unsigned char* Kl, int r32, int hi, const bf16x8 (&qf)[12]) {
    p0 = (f32x16){}; p1 = (f32x16){};
    const int sw = (r32 >> 1) & 7;
    LAS unsigned char* kb[4];
#pragma unroll
    for (int k4 = 0; k4 < 4; ++k4) kb[k4] = Kl + r32 * 128 + (((2 * k4 + hi) ^ sw) << 4);
#pragma unroll
    for (int ks = 0; ks < 12; ++ks) { LAS unsigned char* a = kb[ks & 3] + (ks >> 2) * 8192;
        const bf16x8 b0 = *(const LAS bf16x8*)a, b1 = *(const LAS bf16x8*)(a + 4096);
        p0 = __builtin_amdgcn_mfma_f32_32x32x16_bf16(b0, qf[ks], p0, 0, 0, 0);
        p1 = __builtin_amdgcn_mfma_f32_32x32x16_bf16(b1, qf[ks], p1, 0, 0, 0); }
}
__device__ __forceinline__ void pv_tile(f32x16 (&o)[4], unsigned vb0, bf16x8 pa0, bf16x8 pa1, bf16x8 pa2, bf16x8 pa3) {
#define TRRD(dst, off) asm volatile("ds_read_b64_tr_b16 %0, %1 offset:%2" : "=&v"(dst) : "v"(vb0), "i"(off) : "memory")
#define PV_D0(d0) do { s16x4 l0, l1, l2, l3, h0, h1, h2, h3; constexpr int b_ = v_rd_off(d0, 0, 0); \
        TRRD(l0, b_); TRRD(h0, b_ + 2048); TRRD(l1, b_ + 4096); TRRD(h1, b_ + 6144); TRRD(l2, b_ + 8192); TRRD(h2, b_ + 10240); TRRD(l3, b_ + 12288); TRRD(h3, b_ + 14336); \
        asm volatile("s_waitcnt lgkmcnt(0)" ::: "memory"); SBAR(); \
        o[d0] = __builtin_amdgcn_mfma_f32_32x32x16_bf16(pa0, (bf16x8){l0[0], l0[1], l0[2], l0[3], h0[0], h0[1], h0[2], h0[3]}, o[d0], 0, 0, 0); \
        o[d0] = __builtin_amdgcn_mfma_f32_32x32x16_bf16(pa1, (bf16x8){l1[0], l1[1], l1[2], l1[3], h1[0], h1[1], h1[2], h1[3]}, o[d0], 0, 0, 0); \
        o[d0] = __builtin_amdgcn_mfma_f32_32x32x16_bf16(pa2, (bf16x8){l2[0], l2[1], l2[2], l2[3], h2[0], h2[1], h2[2], h2[3]}, o[d0], 0, 0, 0); \
        o[d0] = __builtin_amdgcn_mfma_f32_32x32x16_bf16(pa3, (bf16x8){l3[0], l3[1], l3[2], l3[3], h3[0], h3[1], h3[2], h3[3]}, o[d0], 0, 0, 0); } while (0)
    PV_D0(0); PV_D0(1); PV_D0(2); PV_D0(3);
#undef PV_D0
#undef TRRD
}
__device__ __forceinline__ void pack_p(const f32x16& p0, const f32x16& p1, bf16x8& pa0, bf16x8& pa1, bf16x8& pa2, bf16x8& pa3) {
#define PK4(P, B_, OUT) do { unsigned a0 = cvtpk(P[B_+0], P[B_+1]), a1 = cvtpk(P[B_+2], P[B_+3]); unsigned b0 = cvtpk(P[B_+4], P[B_+5]), b1 = cvtpk(P[B_+6], P[B_+7]); \
        auto r0 = __builtin_amdgcn_permlane32_swap(a0, b0, false, false); auto r1 = __builtin_amdgcn_permlane32_swap(a1, b1, false, false); \
        v4u w = {r0[0], r1[0], r0[1], r1[1]}; OUT = __builtin_bit_cast(bf16x8, w); } while (0)
    PK4(p0, 0, pa0); PK4(p0, 8, pa1); PK4(p1, 0, pa2); PK4(p1, 8, pa3);
#undef PK4
}
__device__ __forceinline__ float half_max(float v) { auto rr = __builtin_amdgcn_permlane32_swap(__float_as_uint(v), __float_as_uint(v), false, false); return fmaxf(__uint_as_float(rr[0]), __uint_as_float(rr[1])); }
__device__ __forceinline__ float half_sum(float v) { auto rr = __builtin_amdgcn_permlane32_swap(__float_as_uint(v), __float_as_uint(v), false, false); return __uint_as_float(rr[0]) + __uint_as_float(rr[1]); }

__device__ __forceinline__ void mask_tile(f32x16& p0, f32x16& p1, int kb0, int hi, int klo, int khi, bool lb) {
    const float NEG = -__builtin_inff();
    const int dl = klo - kb0 - 4 * hi; const int dh = lb ? khi - kb0 - 4 * hi : -1000000;
#pragma unroll
    for (int r = 0; r < 16; ++r) { const int c = (r & 3) + 8 * (r >> 2);
        if (c < dl || c > dh) p0[r] = NEG;
        if (c + 32 < dl || c + 32 > dh) p1[r] = NEG; }
}
constexpr float ATT_THR = 6.f;
__device__ __forceinline__ void attn_run(LAS unsigned char* L, const bf16* __restrict__ Kg, const bf16* __restrict__ Vg, int jlo, int jhi, unsigned tilebits,
                                         int klo, int khi, unsigned lanebits, const bf16x8 (&qf)[12], f32x16 (&o)[4], float& m_reg, float& l_reg, int tid, int wid, int lane) {
    const int r32 = lane & 31, hi = lane >> 5;
    LAS float* al_l = (LAS float*)(L + ATT_WS + wid * 256);
    const unsigned vb0 = (unsigned)(size_t)(L + ATT_V) + (unsigned)v_rd_base(lane);
    for (int j = jlo; j < jhi; ++j) {
        if (!((tilebits >> (j & 31)) & 1u)) continue;
        const int kb0 = j * 64;
        __syncthreads();
        stage_kv(L, ATT_K, ATT_V, Kg + (size_t)kb0 * DQK, Vg + (size_t)kb0 * DVV, tid);
        __syncthreads();
        const bool lb = (lanebits >> (j & 31)) & 1u;
        const bool lane_any = lb && kb0 <= khi && kb0 + 63 >= klo;
        if (!__any(lane_any)) continue;
        f32x16 p0, p1;
        qkt(p0, p1, L + ATT_K, r32, hi, qf);
        const bool lane_full = lb && kb0 >= klo && kb0 + 63 <= khi;
        if (!__all(lane_full)) mask_tile(p0, p1, kb0, hi, klo, khi, lb);
        float pmax = p0[0];
#pragma unroll
        for (int r = 1; r < 16; ++r) pmax = fmaxf(pmax, p0[r]);
#pragma unroll
        for (int r = 0; r < 16; ++r) pmax = fmaxf(pmax, p1[r]);
        pmax = half_max(pmax);
        float alpha = 1.f;
        if (!__all(pmax - m_reg <= ATT_THR)) { const float mn = fmaxf(m_reg, pmax); alpha = fast_exp2(m_reg - mn); m_reg = mn; }
        float ps = 0.f;
#pragma unroll
        for (int r = 0; r < 16; ++r) { p0[r] = fast_exp2(p0[r] - m_reg); ps += p0[r]; }
#pragma unroll
        for (int r = 0; r < 16; ++r) { p1[r] = fast_exp2(p1[r] - m_reg); ps += p1[r]; }
        ps = half_sum(ps);
        l_reg = l_reg * alpha + ps;
        if (__any(alpha < 1.f)) { if (hi == 0) al_l[r32] = alpha; asm volatile("s_waitcnt lgkmcnt(0)" ::: "memory");
#pragma unroll
            for (int r = 0; r < 16; ++r) { const float a = al_l[crow(r, hi)];
#pragma unroll
                for (int d = 0; d < 4; ++d) o[d][r] *= a; } }
        bf16x8 pa0, pa1, pa2, pa3;
        pack_p(p0, p1, pa0, pa1, pa2, pa3);
        pv_tile(o, vb0, pa0, pa1, pa2, pa3);
    }
}
__device__ __forceinline__ void row_weights(LAS unsigned char* L, int wid, int r32, int hi, float w, float (&rw)[16]) {
    LAS float* li_l = (LAS float*)(L + ATT_WS + wid * 256) + 32;
    if (hi == 0) li_l[r32] = w; asm volatile("s_waitcnt lgkmcnt(0)" ::: "memory");
#pragma unroll
    for (int r = 0; r < 16; ++r) rw[r] = li_l[crow(r, hi)];
    asm volatile("s_waitcnt lgkmcnt(0)" ::: "memory");
}
__device__ __forceinline__ void load_q(bf16x8 (&qf)[12], const bf16* qrow, int hi) {
#pragma unroll
    for (int ks = 0; ks < 12; ++ks) qf[ks] = *(const GAS bf16x8*)(qrow + 16 * ks + 8 * hi);
}

__device__ __forceinline__ void mla_attn_phase(Frame& F, const bf16* QA, const bf16* KA, const bf16* VA, bf16* OA) {
    LAS unsigned char* L = F.lds + RING_OFF; const int tid = F.tid, wid = F.wave, lane = F.lane, r32 = lane & 31, hi = lane >> 5;
    for (int item = F.vcu; item < 512; item += F.G) {
        const int bh = item >> 2, x = item & 3, b = bh >> 5, h = bh & 31;
        for (int pass = 0; pass < 2; ++pass) {
            const int qb = pass ? 7 - x : x;
            const int t = qb * 256 + wid * 32 + r32; const size_t tok = (size_t)b * SEQ + t;
            bf16x8 qf[12]; load_q(qf, QA + tok * UQ_N + h * DQK, hi);
            f32x16 o[4] = {}; float m_reg = -1e30f, l_reg = 0.f;
            attn_run(L, KA + (size_t)bh * SEQ * DQK, VA + (size_t)bh * SEQ * DVV, 0, 4 * qb + 4, 0xffffffffu, 0, t, 0xffffffffu, qf, o, m_reg, l_reg, tid, wid, lane);
            float rw[16]; row_weights(L, wid, r32, hi, 1.f / l_reg, rw);
            bf16* Ow = OA + ((size_t)b * SEQ + qb * 256 + wid * 32) * DM + h * DVV;
#pragma unroll
            for (int r = 0; r < 16; ++r) { const int orow = crow(r, hi);
#pragma unroll
                for (int d0 = 0; d0 < 4; ++d0) { const float v = o[d0][r] * rw[r]; const float vn = __shfl_xor(v, 1);
                    if ((r32 & 1) == 0) *(GAS unsigned*)(Ow + (size_t)orow * DM + d0 * 32 + r32) = cvtpk(v, vn); } }
        }
    }
}
__device__ __forceinline__ f32x16 wave_gemm_tile(const bf16* __restrict__ Arow, const bf16* __restrict__ Wrow, int K, int hi) {
    f32x16 acc = {};
    const bf16* a = Arow + 8 * hi; const bf16* w = Wrow + 8 * hi;
#pragma unroll 8
    for (int k = 0; k < K; k += 16) { const bf16x8 av = *(const GAS bf16x8*)(a + k), wv = *(const GAS bf16x8*)(w + k); acc = __builtin_amdgcn_mfma_f32_32x32x16_bf16(av, wv, acc, 0, 0, 0); }
    return acc;
}
__device__ __forceinline__ void compress1_phase(Frame& F, const bf16* KB0, const bf16* VB0, const bf16* W1K, const bf16* W1V, const float* biasK, const float* biasV, bf16* HIDK, bf16* HIDV) {
    const int gw = F.vcu * NWAVES + F.wave, NGW = F.G * NWAVES, lane = F.lane, r32 = lane & 31, hi = lane >> 5;
    for (int id = gw; id < 384 + 256; id += NGW) {
        const bool isK = id < 384; const int i2 = isK ? id : id - 384; const int nn = isK ? 6 : 4;
        const int grp = i2 / (4 * nn), mt = (i2 / nn) & 3, nt = i2 % nn;
        const int dw = isK ? 192 : 128, K = 32 * dw;
        const bf16* A = (isK ? KB0 : VB0) + ((size_t)grp * SEQ + 16 * (32 * mt + r32)) * dw;
        const bf16* W = (isK ? W1K : W1V) + (size_t)(32 * nt + r32) * K;
        const f32x16 acc = wave_gemm_tile(A, W, K, hi);
        const int n = 32 * nt + r32; const float bias = (isK ? biasK : biasV)[n];
        bf16* H = (isK ? HIDK : HIDV) + (size_t)(grp * 128 + 32 * mt) * dw + n;
#pragma unroll
        for (int r = 0; r < 16; ++r) H[(size_t)crow(r, hi) * dw] = (bf16)f2bf(gelu_tanh(acc[r] + bias));
    }
}
__device__ __forceinline__ void compress2_phase(Frame& F, const bf16* HIDK, const bf16* HIDV, const bf16* W2K, const bf16* W2V, bf16* KC, bf16* VC) {
    const int gw = F.vcu * NWAVES + F.wave, NGW = F.G * NWAVES, lane = F.lane, r32 = lane & 31, hi = lane >> 5;
    for (int id = gw; id < 384 + 256; id += NGW) {
        const bool isK = id < 384; const int i2 = isK ? id : id - 384; const int nn = isK ? 6 : 4;
        const int mt = i2 / nn, nt = i2 % nn;
        const int dw = isK ? 192 : 128;
        const bf16* A = (isK ? HIDK : HIDV) + (size_t)(32 * mt + r32) * dw;
        const bf16* W = (isK ? W2K : W2V) + (size_t)(32 * nt + r32) * dw;
        const f32x16 acc = wave_gemm_tile(A, W, dw, hi);
        bf16* O = (isK ? KC : VC) + (size_t)(32 * mt) * dw + 32 * nt + r32;
#pragma unroll
        for (int r = 0; r < 16; ++r) { const int row = 32 * mt + crow(r, hi); O[(size_t)crow(r, hi) * dw] = (row & 127) == 127 ? (bf16)0 : (bf16)f2bf(acc[r]); }
    }
}

__device__ __forceinline__ void cmp_phase(Frame& F, const bf16* QB, const bf16* KC, const bf16* VC, const float* GATE, float* OC, unsigned* SELM) {
    LAS unsigned char* L = F.lds + RING_OFF; const int tid = F.tid, wid = F.wave, lane = F.lane, r32 = lane & 31, hi = lane >> 5;
    LAS float* IMP = (LAS float*)(L + ATT_IMP);
    LAS float* SC = (LAS float*)(L + ATT_SC);
    LAS unsigned* SELW = (LAS unsigned*)(L + ATT_SELW);
    const unsigned vb0 = (unsigned)(size_t)(L + ATT_V) + (unsigned)v_rd_base(lane);
    for (int unit = F.vcu; unit < 1024; unit += F.G) {
        const int b = unit >> 8, g = (unit >> 6) & 3, ch = unit & 63, t0 = ch * 32, t = t0 + r32; const size_t tok = (size_t)b * SEQ + t; const int head = g * HPG + wid;
        bf16x8 qf[12]; load_q(qf, QB + tok * UQ_N + head * DQK, hi);
        const bf16* Kg = KC + (size_t)(b * NG + g) * 128 * DQK; const bf16* Vg = VC + (size_t)(b * NG + g) * 128 * DVV;
        __syncthreads();
        stage_kv(L, ATT_K, ATT_V, Kg, Vg, tid);
        stage_kv(L, ATT_K2, ATT_V + 16384, Kg + 64 * DQK, Vg + 64 * DVV, tid);
        if (tid < 32) SELW[tid] = 0u;
        __syncthreads();
        f32x16 pA0, pA1, pB0, pB1;
        qkt(pA0, pA1, L + ATT_K, r32, hi, qf);
        qkt(pB0, pB1, L + ATT_K2, r32, hi, qf);
        const int khi = t >= 31 ? ((t - 31) >> 4) : -1;
        mask_tile(pA0, pA1, 0, hi, 0, khi, true);
        mask_tile(pB0, pB1, 64, hi, 0, khi, true);
        float mx = -__builtin_inff();
#pragma unroll
        for (int r = 0; r < 16; ++r) mx = fmaxf(fmaxf(mx, pA0[r]), fmaxf(pA1[r], fmaxf(pB0[r], pB1[r])));
        mx = half_max(mx);
        const float ms = (mx == -__builtin_inff()) ? 0.f : mx;
        float ps = 0.f;
#pragma unroll
        for (int r = 0; r < 16; ++r) { pA0[r] = fast_exp2(pA0[r] - ms); pA1[r] = fast_exp2(pA1[r] - ms); pB0[r] = fast_exp2(pB0[r] - ms); pB1[r] = fast_exp2(pB1[r] - ms); ps += (pA0[r] + pA1[r]) + (pB0[r] + pB1[r]); }
        ps = half_sum(ps);
        const float inv = ps > 0.f ? 1.f / ps : 0.f;
#pragma unroll
        for (int r = 0; r < 16; ++r) { pA0[r] *= inv; pA1[r] *= inv; pB0[r] *= inv; pB1[r] *= inv; }
        LAS float* imp = IMP + (wid * 32 + r32) * 32;
#define IMP_MAIN(P, base) do { _Pragma("unroll") for (int q4 = 0; q4 < 4; ++q4) imp[(base) + hi + 2 * q4] = (P[4 * q4] + P[4 * q4 + 1]) + (P[4 * q4 + 2] + P[4 * q4 + 3]); } while (0)
        IMP_MAIN(pA0, 0); IMP_MAIN(pA1, 8); IMP_MAIN(pB0, 16); IMP_MAIN(pB1, 24);
        asm volatile("s_waitcnt lgkmcnt(0)" ::: "memory");
#define IMP_EXTRA(P, base) do { _Pragma("unroll") for (int q4 = 0; q4 < 4; ++q4) { const int J1 = (base) + hi + 2 * q4 + 1; if (J1 < 32) imp[J1] += P[4 * q4 + 3]; } } while (0)
        IMP_EXTRA(pA0, 0); IMP_EXTRA(pA1, 8); IMP_EXTRA(pB0, 16); IMP_EXTRA(pB1, 24);
#undef IMP_MAIN
#undef IMP_EXTRA
        f32x16 o[4] = {}; bf16x8 pa0, pa1, pa2, pa3;
        pack_p(pA0, pA1, pa0, pa1, pa2, pa3); pv_tile(o, vb0, pa0, pa1, pa2, pa3);
        pack_p(pB0, pB1, pa0, pa1, pa2, pa3); pv_tile(o, vb0 + 16384u, pa0, pa1, pa2, pa3);
        float rw[16]; row_weights(L, wid, r32, hi, GATE[tok * 96 + head * 3 + 0], rw);
        float* Ow = OC + ((size_t)b * SEQ + t0) * DM + head * DVV;
#pragma unroll
        for (int r = 0; r < 16; ++r) { const int orow = crow(r, hi);
#pragma unroll
            for (int d0 = 0; d0 < 4; ++d0) Ow[(size_t)orow * DM + d0 * 32 + r32] = o[d0][r] * rw[r]; }
        __syncthreads();
        { const int tk = tid >> 4, jj = tid & 15, tt = t0 + tk, cur = tt >> 6;
#pragma unroll
          for (int e = 0; e < 2; ++e) { const int j = jj + 16 * e; float s = 0.f;
#pragma unroll
              for (int w = 0; w < 8; ++w) s += IMP[(w * 32 + tk) * 32 + j];
              const bool valid = j <= cur, forced = valid && (j == 0 || j == cur || j == cur - 1);
              SC[tk * 32 + j] = valid ? s + (forced ? 1e4f : 0.f) : -__builtin_inff(); }
          __syncthreads();
          unsigned bits = 0u;
#pragma unroll
          for (int e = 0; e < 2; ++e) { const int j = jj + 16 * e; const float sj = SC[tk * 32 + j]; int rank = 0;
              for (int j2 = 0; j2 < 32; ++j2) { const float s2 = SC[tk * 32 + j2]; rank += (s2 > sj || (s2 == sj && j2 < j)) ? 1 : 0; }
              if (j <= cur && rank < 16) bits |= 1u << j; }
          if (bits) __hip_atomic_fetch_or(&SELW[tk], bits, __ATOMIC_RELAXED, __HIP_MEMORY_SCOPE_WORKGROUP);
          __syncthreads();
          if (tid < 32) SELM[((size_t)b * SEQ + t0 + tid) * NG + g] = SELW[tid]; }
    }
}

__device__ __forceinline__ void selwin_phase(Frame& F, const bf16* QB, const bf16* KB, const bf16* VB, const float* GATE, const float* OC, float* OS, const unsigned* SELM, bf16* OB) {
    LAS unsigned char* L = F.lds + RING_OFF; const int tid = F.tid, wid = F.wave, lane = F.lane, r32 = lane & 31, hi = lane >> 5;
    for (int unit = F.vcu; unit < 1024; unit += F.G) {
        const int b = unit >> 8, g = (unit >> 6) & 3, ch = unit & 63, t0 = ch * 32, t = t0 + r32; const size_t tok = (size_t)b * SEQ + t; const int head = g * HPG + wid;
        bf16x8 qf[12]; load_q(qf, QB + tok * UQ_N + head * DQK, hi);
        const size_t slab = (size_t)(b * NG + g) * SEQ;
        const int jhi = ((t0 + 31) >> 6) + 1;
        const unsigned sel = SELM[tok * NG + g];
        unsigned un = sel;
#pragma unroll
        for (int o_ = 1; o_ < 32; o_ <<= 1) un |= __shfl_xor(un, o_);
        un = __builtin_amdgcn_readfirstlane(un);
        const int wlo = t0 - 511 > 0 ? t0 - 511 : 0, wklo = t - 511 > 0 ? t - 511 : 0;
        const size_t obase = ((size_t)b * SEQ + t0) * DM + head * DVV;
        for (int br = 1; br <= 2; ++br) {
            const bool isw = br == 2;
            f32x16 o[4] = {}; float m_reg = -1e30f, l_reg = 0.f;
            attn_run(L, KB + (size_t)br * KB_BR + slab * DQK, VB + (size_t)br * VB_BR + slab * DVV, isw ? (wlo >> 6) : 0, jhi, isw ? 0xffffffffu : un, isw ? wklo : 0, t, isw ? 0xffffffffu : sel, qf, o, m_reg, l_reg, tid, wid, lane);
            float rw[16]; row_weights(L, wid, r32, hi, GATE[tok * 96 + head * 3 + br] / l_reg, rw);
            unsigned e0 = (unsigned)obase + (unsigned)(4 * hi * DM + r32);
            asm volatile("" : "+v"(e0));
            const GAS char* pb = (const GAS char*)(isw ? OS : OC);
            if (!isw) {
#pragma unroll
                for (int r = 0; r < 16; ++r) { const unsigned er = (e0 + (unsigned)(((r & 3) + 8 * (r >> 2)) * DM)) * 4u;
#pragma unroll
                    for (int d0 = 0; d0 < 4; ++d0) { const float v = *(const GAS float*)(pb + er + d0 * 128) + o[d0][r] * rw[r]; *(GAS float*)((GAS char*)OS + er + d0 * 128) = v; }
                    SBAR(); }
            } else {
#pragma unroll
                for (int r = 0; r < 16; ++r) { const unsigned er = (e0 + (unsigned)(((r & 3) + 8 * (r >> 2)) * DM)) * 4u;
#pragma unroll
                    for (int d0 = 0; d0 < 4; ++d0) { const float v = *(const GAS float*)(pb + er + d0 * 128) + o[d0][r] * rw[r]; const float vn = __shfl_xor(v, 1);
                        if ((r32 & 1) == 0) *(GAS unsigned*)((GAS char*)OB + (er >> 1) + d0 * 64) = cvtpk(v, vn); }
                    SBAR(); }
            }
        }
    }
}
constexpr int N_PHASES = 20;
struct Args { const float* in[24]; float* out; unsigned char* ws; int ph_lo, ph_hi; };
__global__ void __launch_bounds__(NWAVES * 64, 2) yoco_fwd(Args args) {
    extern __shared__ __attribute__((aligned(16))) unsigned char lds[];
    Frame F;
    F.lds = (LAS unsigned char*)lds;
    F.MISC = (volatile LAS unsigned*)(F.lds + MISC_OFF);
    F.tid = threadIdx.x; F.lane = F.tid & 63; F.wave = __builtin_amdgcn_readfirstlane(F.tid >> 6);
    F.G = gridDim.x; { const int bx = blockIdx.x; F.vcu = (F.G % 8 == 0) ? (bx % 8) * (F.G / 8) + bx / 8 : bx; }
    unsigned char* ws = args.ws; F.ws = ws;
    F.ctl = (gu32*)(ws + WS_CTL);
    for (int u = F.tid; u < (LDS_BYTES - LDSCTL_OFF) / 4; u += NWAVES * 64) ((LAS unsigned*)(F.lds + LDSCTL_OFF))[u] = 0u;
    __syncthreads();
    XcdBarrier bar = xcd_barrier_post((unsigned*)(F.ctl + CW_BAR), F.MISC + 8);
    const int lo = args.ph_lo, hi = args.ph_hi;
#ifndef PH_MASK
#define PH_MASK 0xFFFFFu
#endif
#define IN(k) (((PH_MASK >> (k)) & 1u) && lo <= (k) && (k) < hi)
#define INR(k) (lo <= (k) && (k) < hi)
#define SEAM(k) do { if (INR(k) && INR((k) + 1)) xcd_barrier(bar); } while (0)

    LAS unsigned char* RING = F.lds + RING_OFF;
    const int bid = (int)blockIdx.x;

    if (IN(0)) {
        conv_matrix(F, args.in[3], A_IN, args.in[2], (bf16*)(ws + WS_WA), DM, A_IN_PAD, 0, MapLim{A_IN}, MapId{});
        conv_matrix(F, args.in[5], UQ_N, args.in[4], (bf16*)(ws + WS_WUQ), QL, UQ_N, 0, MapUq{}, MapId{});
        conv_matrix(F, args.in[7], UKV_N, args.in[6], (bf16*)(ws + WS_WUKV), KVL, UKV_N, 0, MapId{}, MapId{});
        conv_matrix(F, args.in[8], DM, nullptr, (bf16*)(ws + WS_WOA), DM, DM, 0, MapId{}, MapId{});
        for (int l = 0; l < 2; ++l) {
            conv_matrix(F, args.in[21] + (size_t)l * DM * 2 * FF, 2 * FF, args.in[20] + (size_t)l * DM, (bf16*)(ws + WS_WFI + l * WFI_STRIDE), DM, 2 * FF, 0, MapFfi{}, MapId{});
            conv_matrix(F, args.in[22] + (size_t)l * FF * DM, DM, nullptr, (bf16*)(ws + WS_WFO + l * WFO_STRIDE), FF, DM, 0, MapId{}, MapId{});
        }
        conv_matrix(F, args.in[10], 3840, args.in[9], (bf16*)(ws + WS_WSB), DM, 3840, 0, MapSkv{}, MapId{});
        conv_matrix(F, args.in[18], 6240, args.in[17], (bf16*)(ws + WS_WSB), DM, 6400, 3840, MapBin{}, MapId{});
        conv_matrix(F, args.in[19], DM, nullptr, (bf16*)(ws + WS_WOB), DM, DM, 0, MapId{}, MapId{});
        conv_matrix(F, args.in[12], 192, nullptr, (bf16*)(ws + WS_W1K), 6144, 192, 0, MapId{}, MapW1kRow{});
        conv_matrix(F, args.in[13], 192, nullptr, (bf16*)(ws + WS_W2K), 192, 192, 0, MapW2kCol{}, MapId{});
        conv_matrix(F, args.in[15], 128, nullptr, (bf16*)(ws + WS_W1V), 4096, 128, 0, MapId{}, MapId{});
        conv_matrix(F, args.in[16], 128, nullptr, (bf16*)(ws + WS_W2V), 128, 128, 0, MapId{}, MapId{});
        rope_tables(F, (const int*)args.in[1], (f32x2*)(ws + WS_TABA), (f32x2*)(ws + WS_TABB));
        pe_bias(F, args.in[11], args.in[12], 6144, 192, (float*)(ws + WS_BIAS));
        pe_bias(F, args.in[14], args.in[15], 4096, 128, (float*)(ws + WS_BIAS) + 256);
        norm_phase(F, args.in[0], (bf16*)(ws + WS_XN));
    }
    SEAM(0);
    if (IN(1)) { pg8::Gemm g{(const bf16*)(ws + WS_XN), (const bf16*)(ws + WS_WA), M, A_IN_PAD, DM}; pg8::StaticOrder S; S.init(M, A_IN_PAD, F.G, bid);
        EpiRow8<FnUA> E{FnUA{(float*)(ws + WS_UA)}}; pg8::gemm_phase<EpiRow8<FnUA>, pg8::StaticOrder, true, true>(RING, g, S, E); }
    SEAM(1);
    if (IN(2)) mla_latent_phase(F, (const float*)(ws + WS_UA), (bf16*)(ws + WS_CQ), (bf16*)(ws + WS_CKV), (bf16*)(ws + WS_KA), (const f32x2*)(ws + WS_TABA));
    SEAM(2);
    if (IN(3)) {
        { pg8::Gemm g{(const bf16*)(ws + WS_CQ), (const bf16*)(ws + WS_WUQ), M, UQ_N, QL}; pg8::StaticOrder S; S.init(M, UQ_N, F.G, bid);
          EpiRow8<FnQa> E{FnQa{(bf16*)(ws + WS_QA), (const f32x2*)(ws + WS_TABA)}}; pg8::gemm_phase<EpiRow8<FnQa>, pg8::StaticOrder, true, true>(RING, g, S, E); }
        __syncthreads();
        { pg8::Gemm g{(const bf16*)(ws + WS_CKV), (const bf16*)(ws + WS_WUKV), M, UKV_N, KVL}; pg8::StaticOrder S; S.init(M, UKV_N, F.G, bid);
          EpiRow8<FnKVa> E{FnKVa{(bf16*)(ws + WS_KA), (bf16*)(ws + WS_VA)}}; pg8::gemm_phase<EpiRow8<FnKVa>, pg8::StaticOrder, true, true>(RING, g, S, E); }
    }
    SEAM(3);
    if (IN(4)) mla_attn_phase(F, (const bf16*)(ws + WS_QA), (const bf16*)(ws + WS_KA), (const bf16*)(ws + WS_VA), (bf16*)(ws + WS_OA));
    SEAM(4);
    if (IN(5)) { pg8::Gemm g{(const bf16*)(ws + WS_OA), (const bf16*)(ws + WS_WOA), M, DM, DM}; pg8::StaticOrder S; S.init(M, DM, F.G, bid);
        EpiRow8<FnResNew> E{FnResNew{args.in[0], (float*)(ws + WS_H)}}; pg8::gemm_phase<EpiRow8<FnResNew>, pg8::StaticOrder, true, true>(RING, g, S, E); }
    SEAM(5);
#define FFN_PHASES(layer, pb) do { \
        if (IN((pb) + 6)) norm_phase(F, (const float*)(ws + WS_H), (bf16*)(ws + WS_XN)); \
        SEAM((pb) + 6); \
        if (IN((pb) + 7)) { pg8::Gemm g{(const bf16*)(ws + WS_XN), (const bf16*)(ws + WS_WFI + (layer) * WFI_STRIDE), M, 2 * FF, DM}; pg8::StaticOrder S; S.init(M, 2 * FF, F.G, bid); \
            EpiGate<FnSwiglu> E{FnSwiglu{(bf16*)(ws + WS_ACT)}}; pg8::gemm_phase<EpiGate<FnSwiglu>, pg8::StaticOrder, true, true>(RING, g, S, E); } \
        SEAM((pb) + 7); \
        if (IN((pb) + 8)) { pg8::Gemm g{(const bf16*)(ws + WS_ACT), (const bf16*)(ws + WS_WFO + (layer) * WFO_STRIDE), M, DM, FF}; pg8::StaticOrder S; S.init(M, DM, F.G, bid); \
            EpiRow8<FnResAcc> E{FnResAcc{(float*)(ws + WS_H)}}; pg8::gemm_phase<EpiRow8<FnResAcc>, pg8::StaticOrder, true, true>(RING, g, S, E); } \
        SEAM((pb) + 8); } while (0)
    FFN_PHASES(0, 0);
    if (IN(9)) norm_phase(F, (const float*)(ws + WS_H), (bf16*)(ws + WS_XN));
    SEAM(9);
    if (IN(10)) { pg8::Gemm g{(const bf16*)(ws + WS_XN), (const bf16*)(ws + WS_WSB), M, SB_N, DM}; pg8::StaticOrder S; S.init(M, SB_N, F.G, bid);
        EpiSB E{(bf16*)(ws + WS_KB), (bf16*)(ws + WS_VB), (bf16*)(ws + WS_QA), (float*)(ws + WS_GATE), (const f32x2*)(ws + WS_TABB)}; pg8::gemm_phase<EpiSB, pg8::StaticOrder, true, true>(RING, g, S, E); }
    SEAM(10);
    if (IN(11)) compress1_phase(F, (const bf16*)(ws + WS_KB), (const bf16*)(ws + WS_VB), (const bf16*)(ws + WS_W1K), (const bf16*)(ws + WS_W1V), (const float*)(ws + WS_BIAS), (const float*)(ws + WS_BIAS) + 256, (bf16*)(ws + WS_HIDK), (bf16*)(ws + WS_HIDV));
    SEAM(11);
    if (IN(12)) compress2_phase(F, (const bf16*)(ws + WS_HIDK), (const bf16*)(ws + WS_HIDV), (const bf16*)(ws + WS_W2K), (const bf16*)(ws + WS_W2V), (bf16*)(ws + WS_KC), (bf16*)(ws + WS_VC));
    SEAM(12);
    if (IN(13)) cmp_phase(F, (const bf16*)(ws + WS_QA), (const bf16*)(ws + WS_KC), (const bf16*)(ws + WS_VC), (const float*)(ws + WS_GATE), (float*)(ws + WS_OC), (unsigned*)(ws + WS_SEL));
    SEAM(13);
    if (IN(14)) selwin_phase(F, (const bf16*)(ws + WS_QA), (const bf16*)(ws + WS_KB), (const bf16*)(ws + WS_VB), (const float*)(ws + WS_GATE), (const float*)(ws + WS_OC), (float*)(ws + WS_OS), (const unsigned*)(ws + WS_SEL), (bf16*)(ws + WS_OA));
    SEAM(14);
    if (IN(15)) { pg8::Gemm g{(const bf16*)(ws + WS_OA), (const bf16*)(ws + WS_WOB), M, DM, DM}; pg8::StaticOrder S; S.init(M, DM, F.G, bid);
        EpiRow8<FnResAcc> E{FnResAcc{(float*)(ws + WS_H)}}; pg8::gemm_phase<EpiRow8<FnResAcc>, pg8::StaticOrder, true, true>(RING, g, S, E); }
    SEAM(15);
    FFN_PHASES(1, 10);
    if (IN(19)) final_norm_phase(F, (const float*)(ws + WS_H), args.in[23], args.out);
#undef FFN_PHASES
#undef IN
#undef INR
#undef SEAM
}

extern "C" void kernel_launch(void* const* d_in, const int* in_sizes, int n_in, void* d_out, int out_size, void* d_ws, size_t ws_size, hipStream_t stream) {
    static int grid = 0;
    if (grid == 0) {
        if (n_in != 24 || out_size != M * DM || ws_size < WS_END) { fprintf(stderr, "kernel_launch: unexpected shapes (n_in %d out %d ws %zu need %zu)\n", n_in, out_size, ws_size, (size_t)WS_END); grid = -1; return; }
        int dev = 0, cus = 0, per_cu = 0;
        if (hipGetDevice(&dev) != hipSuccess || hipDeviceGetAttribute(&cus, hipDeviceAttributeMultiprocessorCount, dev) != hipSuccess) { grid = -1; return; }
        if (hipFuncSetAttribute((const void*)yoco_fwd, hipFuncAttributeMaxDynamicSharedMemorySize, LDS_BYTES) != hipSuccess) { fprintf(stderr, "kernel_launch: hipFuncSetAttribute failed\n"); grid = -1; return; }
        if (hipOccupancyMaxActiveBlocksPerMultiprocessor(&per_cu, (const void*)yoco_fwd, NWAVES * 64, LDS_BYTES) != hipSuccess || per_cu < 1)
            fprintf(stderr, "kernel_launch: occupancy query reports %d workgroups per CU\n", per_cu);
        (void)hipGetLastError();
        grid = cus;
    }
    if (grid < 0) return;
    if (hipMemsetAsync((char*)d_ws + WS_CTL, 0, CTL_ZERO_BYTES, stream) != hipSuccess) return;
    Args a{};
    for (int i = 0; i < 24; ++i) a.in[i] = (const float*)d_in[i];
    a.out = (float*)d_out; a.ws = (unsigned char*)d_ws;
#if MK_ONE_LAUNCH
    a.ph_lo = 0; a.ph_hi = N_PHASES;
    hipLaunchKernelGGL(yoco_fwd, dim3(grid), dim3(NWAVES * 64), LDS_BYTES, stream, a);
#else
    for (int p = 0; p < N_PHASES; ++p) { a.ph_lo = p; a.ph_hi = p + 1; hipLaunchKernelGGL(yoco_fwd, dim3(grid), dim3(NWAVES * 64), LDS_BYTES, stream, a); }
#endif
}
```

```cpp
#include <hip/hip_runtime.h>
#include <cstdio>
#include <cstdint>
#include <cmath>
#define MK_ONE_LAUNCH 1
namespace pg8 {
#define PG8_LAS __attribute__((address_space(3)))
typedef unsigned short bf16_t;
typedef short bf16x8 __attribute__((ext_vector_type(8)));
typedef float f32x4 __attribute__((ext_vector_type(4)));
typedef unsigned u32x4 __attribute__((ext_vector_type(4)));
typedef int i32x4_t __attribute__((ext_vector_type(4)));
constexpr int BM = 256, BK = 64, HALF = 128, HTB = HALF * BK * 2  , STAGE_BYTES = 8 * HTB, NXCD = 8, WGM = 8;

__host__ __device__ __forceinline__ int lds_byte(int r, int c) { const int st = (r >> 4) * 2 + (c >> 5), rr = r & 15, cc = c & 31, ob = rr * 64 + cc * 2; return st * 1024 + (ob ^ (((ob >> 9) & 1) << 5)); }
__host__ __device__ __forceinline__ void stage_rc(int b, int& R, int& C) { const int st = b / 1024, sb = b % 1024, swz = sb ^ (((sb >> 9) & 1) << 5); R = (st >> 1) * 16 + swz / 64; C = (st & 1) * 32 + (swz % 64) / 2; }
__host__ __device__ __forceinline__ int perm32(int rho) { const int n = rho >> 4, i = rho & 15; return 8 * (i >> 2) + 4 * n + (i & 3); }

struct Unit { int pm, pn; };
struct Gemm { const bf16_t* A; const bf16_t* Bt; int M, N, K; };

struct StaticOrder {
    int nM, nN, nwg, G, c;
    __host__ __device__ void init(int M, int N, int G_, int c_) { nM = M / BM; nN = N / BM; nwg = nM * nN; G = G_; c = c_; }
    __host__ __device__ bool next(int i, Unit& u) const {
        const long L = (long)i * G + c; if (L >= nwg) return false;
        int wgid = (int)L; { const int q = nwg / NXCD, r = nwg % NXCD, xcd = wgid % NXCD, off = wgid / NXCD; wgid = (xcd < r ? xcd * (q + 1) : r * (q + 1) + (xcd - r) * q) + off; }
        const int nig = WGM * nN, gid = wgid / nig, fm = gid * WGM, gsz = (nM - fm) < WGM ? (nM - fm) : WGM;
        u.pm = fm + ((wgid % nig) % gsz); u.pn = (wgid % nig) / gsz; return true;
    }
    __device__ __forceinline__ void a_ready(const Unit&) const {}
    __device__ __forceinline__ void done(const Unit&) const {}
};

__device__ __forceinline__ unsigned cvt_pk_bf16(float lo, float hi) { unsigned r; asm volatile("v_cvt_pk_bf16_f32 %0, %1, %2" : "=v"(r) : "v"(lo), "v"(hi)); return r; }
template <class Epi, class Sched, bool ALIGN_EPI = false, bool SP2 = false, bool AT = false, bool BT = false, bool I8 = false>
__device__ __forceinline__ void gemm_phase(PG8_LAS unsigned char* lds, const Gemm g, const Sched& S, const Epi& E, const int wave_id  ) {
    unsigned zz_; asm volatile("v_mov_b32 %0, 0" : "=v"(zz_)); const int lane = (int)__builtin_amdgcn_mbcnt_hi(~0u, __builtin_amdgcn_mbcnt_lo(~0u, zz_));
    const int wid = wave_id, tid = wid * 64 + lane, wr = wid >> 2, wc = wid & 3, fr = lane & 15, fq = lane >> 4;
    const int K = g.K, nt = K / BK;
    unsigned voffA[2], voffB[2];
#pragma unroll
    for (int i = 0; i < 2; ++i) { int R, C; stage_rc(tid * 16 + i * 8192, R, C); const int Rb = Epi::PERM ? ((R & ~31) + perm32(R & 31)) : R;
        voffA[i] = (unsigned)(R * (AT ? BK : K) + C) * 2u; voffB[i] = (unsigned)(Rb * (BT ? BK : K) + C) * 2u; }
    const size_t kstepA = AT ? (size_t)(BM * BK * 2) : (size_t)(BK * 2), kstepB = BT ? (size_t)(BM * BK * 2) : (size_t)(BK * 2);
    const size_t hstepA = AT ? (size_t)(HALF * BK * 2) : (size_t)HALF * K * 2, hstepB = BT ? (size_t)(HALF * BK * 2) : (size_t)HALF * K * 2;
    const size_t tstep = (size_t)BM * K * 2;
    const unsigned ldsw = (unsigned)wid * 1024u;
    const int aoff = lds_byte(wr * 64 + fr, fq * 8), boff = lds_byte(wc * 32 + fr, fq * 8);
#define PG8_SA(b, h) (((b) * 2 + (h)) * HTB)
#define PG8_SB(b, h) ((4 + (b) * 2 + (h)) * HTB)
#define PG8_STAGE(bufoff, gbase, voff) do { _Pragma("unroll") for (int _i = 0; _i < 2; ++_i) \
        __builtin_amdgcn_global_load_lds((const unsigned*)((const char*)(gbase) + (voff)[_i]), (PG8_LAS unsigned*)(lds + (bufoff) + ldsw + _i * 8192), 16, 0, 0); } while (0)
#define PG8_LDA(dst, b, h) do { _Pragma("unroll") for (int m = 0; m < 4; ++m) _Pragma("unroll") for (int k = 0; k < 2; ++k) dst[m][k] = *(const PG8_LAS bf16x8*)(lds + PG8_SA(b, h) + aoff + m * 2048 + k * 1024); } while (0)
#define PG8_LDB(dst, b, h) do { _Pragma("unroll") for (int n = 0; n < 2; ++n) _Pragma("unroll") for (int k = 0; k < 2; ++k) dst[n][k] = *(const PG8_LAS bf16x8*)(lds + PG8_SB(b, h) + boff + n * 2048 + k * 1024); } while (0)
#define PG8_MMA(ai, bj, At, Bt) do { __builtin_amdgcn_s_setprio(1); _Pragma("unroll") for (int m = 0; m < 4; ++m) _Pragma("unroll") for (int n = 0; n < 2; ++n) _Pragma("unroll") for (int k = 0; k < 2; ++k) { \
        if constexpr (I8) acc[ai][bj][m][n] = __builtin_bit_cast(f32x4, __builtin_amdgcn_mfma_i32_16x16x64_i8(__builtin_bit_cast(i32x4_t, Bt[n][k]), __builtin_bit_cast(i32x4_t, At[m][k]), __builtin_bit_cast(i32x4_t, acc[ai][bj][m][n]), 0, 0, 0)); \
        else acc[ai][bj][m][n] = __builtin_amdgcn_mfma_f32_16x16x32_bf16(Bt[n][k], At[m][k], acc[ai][bj][m][n], 0, 0, 0); } __builtin_amdgcn_s_setprio(0); } while (0)
#define PG8_WAIT_V(n) asm volatile("s_waitcnt vmcnt(" #n ")" ::: "memory")
#define PG8_WAIT_L(n) asm volatile("s_waitcnt lgkmcnt(" #n ")" ::: "memory")
#define PG8_BAR __builtin_amdgcn_s_barrier()
#define PG8_SCHED __builtin_amdgcn_sched_barrier(0)
    Unit cur, nxt; int ui = 0;
    if (!S.next(0, cur)) return;
    f32x4 acc[2][2][4][2];
#pragma unroll
    for (int a = 0; a < 2; ++a)
#pragma unroll
        for (int b = 0; b < 2; ++b)
#pragma unroll
            for (int m = 0; m < 4; ++m)
#pragma unroll
                for (int n = 0; n < 2; ++n) acc[a][b][m][n] = (f32x4){0.f, 0.f, 0.f, 0.f};
    bf16x8 At[4][2], B0[2][2], B1[2][2];
    const char* cA = (const char*)g.A + (size_t)cur.pm * tstep; const char* cB = (const char*)g.Bt + (size_t)cur.pn * tstep;
    S.a_ready(cur);
    if constexpr (SP2) {
        PG8_STAGE(PG8_SB(0, 0), cB, voffB); PG8_STAGE(PG8_SB(0, 1), cB + hstepB, voffB); PG8_STAGE(PG8_SA(0, 0), cA, voffA); PG8_STAGE(PG8_SA(0, 1), cA + hstepA, voffA);
        if (wr == 1) PG8_BAR;
        PG8_WAIT_V(2); PG8_BAR;
        PG8_STAGE(PG8_SB(1, 0), cB + kstepB, voffB); PG8_STAGE(PG8_SA(1, 0), cA + kstepA, voffA); PG8_STAGE(PG8_SB(1, 1), cB + hstepB + kstepB, voffB);
        PG8_WAIT_V(6); PG8_BAR;
    } else {
        PG8_STAGE(PG8_SB(0, 0), cB, voffB); PG8_STAGE(PG8_SA(0, 0), cA, voffA); PG8_STAGE(PG8_SB(0, 1), cB + hstepB, voffB); PG8_STAGE(PG8_SA(0, 1), cA + hstepA, voffA);
        if (wr == 1) PG8_BAR;
        PG8_WAIT_V(4); PG8_BAR;
        PG8_STAGE(PG8_SB(1, 0), cB + kstepB, voffB); PG8_STAGE(PG8_SA(1, 0), cA + kstepA, voffA); PG8_STAGE(PG8_SB(1, 1), cB + hstepB + kstepB, voffB);
        PG8_WAIT_V(6); PG8_BAR;
    }
    for (;;) {
        const bool has_next = S.next(ui + 1, nxt);
        const char* nA = has_next ? (const char*)g.A + (size_t)nxt.pm * tstep : cA; const char* nB = has_next ? (const char*)g.Bt + (size_t)nxt.pn * tstep : cB;
        for (int t = 0; t < nt; t += 2) {
            const bool last = (t == nt - 2);
            const char* a1 = cA + (size_t)(t + 1) * kstepA;
            const char* a2 = last ? nA : cA + (size_t)(t + 2) * kstepA; const char* b2 = last ? nB : cB + (size_t)(t + 2) * kstepB;
            const char* a3 = a2 + kstepA; const char* b3 = b2 + kstepB;
            if (last && has_next) S.a_ready(nxt);
            if constexpr (SP2) {
            PG8_LDB(B0, 0, 0); PG8_LDB(B1, 0, 1); PG8_SCHED; PG8_LDA(At, 0, 0); PG8_STAGE(PG8_SA(1, 1), a1 + hstepA, voffA);
            PG8_WAIT_V(8); PG8_WAIT_L(0); PG8_BAR; PG8_MMA(0, 0, At, B0); PG8_MMA(0, 1, At, B1); PG8_BAR; PG8_SCHED;
            PG8_LDA(At, 0, 1); PG8_STAGE(PG8_SB(0, 0), b2, voffB); PG8_STAGE(PG8_SB(0, 1), b2 + hstepB, voffB); PG8_STAGE(PG8_SA(0, 0), a2, voffA);
            PG8_WAIT_V(8); PG8_WAIT_L(0); PG8_BAR; PG8_MMA(1, 0, At, B0); PG8_MMA(1, 1, At, B1); PG8_BAR; PG8_SCHED;
            PG8_LDB(B0, 1, 0); PG8_LDB(B1, 1, 1); PG8_SCHED; PG8_LDA(At, 1, 0); PG8_STAGE(PG8_SA(0, 1), a2 + hstepA, voffA);
            PG8_WAIT_V(8); PG8_WAIT_L(0); PG8_BAR; PG8_MMA(0, 0, At, B0); PG8_MMA(0, 1, At, B1); PG8_BAR; PG8_SCHED;
            PG8_LDA(At, 1, 1); PG8_STAGE(PG8_SB(1, 0), b3, voffB); PG8_STAGE(PG8_SB(1, 1), b3 + hstepB, voffB); PG8_STAGE(PG8_SA(1, 0), a3, voffA);
            PG8_WAIT_V(8); PG8_WAIT_L(0); PG8_BAR; PG8_MMA(1, 0, At, B0); PG8_MMA(1, 1, At, B1); PG8_BAR; PG8_SCHED;
            } else {
            PG8_LDB(B0, 0, 0); PG8_SCHED; PG8_LDA(At, 0, 0); PG8_STAGE(PG8_SA(1, 1), a1 + hstepA, voffA);
            PG8_WAIT_L(8); PG8_BAR; PG8_WAIT_L(0); PG8_MMA(0, 0, At, B0); PG8_BAR; PG8_SCHED;
            PG8_LDB(B1, 0, 1); PG8_STAGE(PG8_SB(0, 0), b2, voffB);
            PG8_BAR; PG8_WAIT_L(0); PG8_MMA(0, 1, At, B1); PG8_BAR;
            PG8_LDA(At, 0, 1); PG8_STAGE(PG8_SA(0, 0), a2, voffA);
            PG8_BAR; PG8_WAIT_L(0); PG8_MMA(1, 0, At, B0); PG8_BAR; PG8_SCHED;
            PG8_STAGE(PG8_SB(0, 1), b2 + hstepB, voffB);
            PG8_WAIT_V(6); PG8_BAR; PG8_MMA(1, 1, At, B1); PG8_BAR;
            PG8_LDB(B0, 1, 0); PG8_SCHED; PG8_LDA(At, 1, 0); PG8_STAGE(PG8_SA(0, 1), a2 + hstepA, voffA);
            PG8_WAIT_L(8); PG8_BAR; PG8_WAIT_L(0); PG8_MMA(0, 0, At, B0); PG8_BAR; PG8_SCHED;
            PG8_LDB(B1, 1, 1); PG8_STAGE(PG8_SB(1, 0), b3, voffB);
            PG8_BAR; PG8_WAIT_L(0); PG8_MMA(0, 1, At, B1); PG8_BAR;
            PG8_LDA(At, 1, 1); PG8_STAGE(PG8_SA(1, 0), a3, voffA);
            PG8_BAR; PG8_WAIT_L(0); PG8_MMA(1, 0, At, B0); PG8_BAR; PG8_SCHED;
            PG8_STAGE(PG8_SB(1, 1), b3 + hstepB, voffB);
            PG8_WAIT_V(6); PG8_BAR; PG8_MMA(1, 1, At, B1); PG8_BAR;
            }
        }
        if constexpr (ALIGN_EPI) { if (wr == 0) PG8_BAR; }
        if constexpr (!Epi::AFTER_DRAIN) { E(acc, cur, wr, wc, fr, fq); S.done(cur); }
        if (!has_next) break;
#pragma unroll
        for (int a = 0; a < 2; ++a)
#pragma unroll
            for (int b = 0; b < 2; ++b)
#pragma unroll
                for (int m = 0; m < 4; ++m)
#pragma unroll
                    for (int n = 0; n < 2; ++n) acc[a][b][m][n] = (f32x4){0.f, 0.f, 0.f, 0.f};
        cur = nxt; cA = nA; cB = nB; ++ui;
        if constexpr (ALIGN_EPI) { if (wr == 1) PG8_BAR; }
    }
    PG8_WAIT_V(0);
    if constexpr (!ALIGN_EPI) { if (wr == 0) PG8_BAR; }
    PG8_BAR;
    if constexpr (Epi::AFTER_DRAIN) { E.fused(acc, cur, wr, wc, fr, fq, lds, wid, lane); S.done(cur); }
#undef PG8_SA
#undef PG8_SB
#undef PG8_STAGE
#undef PG8_LDA
#undef PG8_LDB
#undef PG8_MMA
#undef PG8_WAIT_V
#undef PG8_WAIT_L
#undef PG8_BAR
#undef PG8_SCHED
}
}
#define GAS __attribute__((address_space(1)))
#define LAS __attribute__((address_space(3)))
typedef unsigned short bf16;
typedef unsigned v4u __attribute__((ext_vector_type(4)));
typedef float f32x4 __attribute__((ext_vector_type(4)));
typedef short bf16x8 __attribute__((ext_vector_type(8)));
typedef GAS unsigned gu32;
typedef GAS unsigned long long gu64;
#define RLX_AGENT __ATOMIC_RELAXED, __HIP_MEMORY_SCOPE_AGENT
#define LDS_WAIT() asm volatile("s_waitcnt lgkmcnt(0)" ::: "memory")
#define VM_WAIT() asm volatile("s_waitcnt vmcnt(0)" ::: "memory")
__device__ __forceinline__ unsigned long long rt() { return __builtin_amdgcn_s_memrealtime(); }
__device__ __forceinline__ unsigned f2bf(float f) { unsigned u = __builtin_bit_cast(unsigned, f); return (u + 0x7fffu + ((u >> 16) & 1u)) >> 16; }
__device__ __forceinline__ unsigned pk2(float lo, float hi) { return f2bf(lo) | (f2bf(hi) << 16); }
#define XB_TMO      128
#define XB_XCNT(j)  (256  + 64 * (j))
#define XB_XSUB(j)  (1280 + 64 * (j))
#define XB_XGEN(j)  (2304 + 64 * (j))
#define XB_TOP      3328
#define XB_TOPGEN   3392
#define XCD_BAR_WORDS 3456
#define XB_SPIN_CAP (1u << 18)

__device__ __forceinline__ unsigned xb_ld(unsigned* p)              { return __hip_atomic_load(p, __ATOMIC_RELAXED, __HIP_MEMORY_SCOPE_AGENT); }
__device__ __forceinline__ unsigned xb_add(unsigned* p, unsigned v) { return __hip_atomic_fetch_add(p, v, __ATOMIC_RELAXED, __HIP_MEMORY_SCOPE_AGENT); }
__device__ __forceinline__ unsigned xb_xcc_id() { return (unsigned)__builtin_amdgcn_s_getreg((3 << 11) | 20) & 0xFu; }
#define XB_SPIN(cond, bar) do { unsigned _sp = 0; while (cond) { __builtin_amdgcn_s_sleep(1); \
    if ((++_sp & 255u) == 0u) { if (xb_ld(&(bar)[XB_TMO])) break; if (_sp > XB_SPIN_CAP) { atomicAdd(&(bar)[XB_TMO], 1u); break; } } } } while (0)

struct XcdBarrier {
    unsigned* bar; unsigned x; unsigned w0;
    volatile LAS unsigned* st;
};

__device__ __forceinline__ XcdBarrier xcd_barrier_post(unsigned* bar, volatile LAS unsigned* st) {
    XcdBarrier b; b.bar = bar; b.x = xb_xcc_id(); b.st = st; b.w0 = (unsigned)__builtin_amdgcn_readfirstlane((int)(threadIdx.x >> 6)) == 0u ? 1u : 0u;
    if (threadIdx.x == 0) (void)xb_add(&bar[XB_XCNT(b.x)], 1u);
    return b;
}
__device__ __forceinline__ void xcd_barrier_complete(unsigned* bar, unsigned x, unsigned& nloc, unsigned& nx) {
    const unsigned G = gridDim.x * gridDim.y * gridDim.z;
    unsigned sum, cnt, mine, sp = 0u;
    for (;;) {
        sum = 0u; cnt = 0u; mine = 0u;
#pragma unroll
        for (unsigned j = 0; j < 16; ++j) { const unsigned c = xb_ld(&bar[XB_XCNT(j)]); sum += c; cnt += (c > 0u) ? 1u : 0u; mine = (j == x) ? c : mine; }
        if (sum == G) break;
        __builtin_amdgcn_s_sleep(1);
        if ((++sp & 255u) == 0u) { if (xb_ld(&bar[XB_TMO])) break; if (sp > XB_SPIN_CAP) { atomicAdd(&bar[XB_TMO], 1u); break; } }
    }
    nloc = mine > 0u ? mine : 1u; nx = cnt > 0u ? cnt : 1u;
}

__device__ __forceinline__ void xcd_barrier(const XcdBarrier& b) {
    asm volatile("s_waitcnt vmcnt(0)" ::: "memory");
    __syncthreads();
    unsigned zb_; asm volatile("v_mov_b32 %0, 0" : "=v"(zb_));
    if (b.w0 && __builtin_amdgcn_mbcnt_hi(~0u, __builtin_amdgcn_mbcnt_lo(~0u, zb_)) == 0u) {
        unsigned* bar = b.bar;
        __builtin_amdgcn_s_waitcnt(0);
        unsigned nloc = b.st[0], nx = b.st[1];
        if (nloc == 0u) { xcd_barrier_complete(bar, b.x, nloc, nx); b.st[0] = nloc; b.st[1] = nx; }
        const unsigned old = xb_add(&bar[XB_XSUB(b.x)], 1u);
        const unsigned gen = old / nloc;
        if (old + 1u == (gen + 1u) * nloc) {
            __builtin_amdgcn_fence(__ATOMIC_RELEASE, "agent");
            asm volatile("s_waitcnt vmcnt(0)" ::: "memory");
            const unsigned og = xb_add(&bar[XB_TOP], 1u);
            const unsigned tg = og / nx;
            if (og + 1u == (tg + 1u) * nx) xb_add(&bar[XB_TOPGEN], 1u);
            else XB_SPIN(xb_ld(&bar[XB_TOPGEN]) == tg, bar);
            __builtin_amdgcn_fence(__ATOMIC_ACQUIRE, "agent");
            xb_add(&bar[XB_XGEN(b.x)], 1u);
            asm volatile("s_waitcnt vmcnt(0)" ::: "memory");
        } else {
            XB_SPIN(xb_ld(&bar[XB_XGEN(b.x)]) == gen, bar);
            __builtin_amdgcn_fence(__ATOMIC_ACQUIRE, "agent");
            asm volatile("s_waitcnt vmcnt(0)" ::: "memory");
        }
    }
    __syncthreads();
}
constexpr int NB = 4, SEQ = 2048, M = NB * SEQ, DM = 4096, FF = 11008;
constexpr int QL = 1536, KVL = 512, A_IN = 2112, A_IN_PAD = 2304;
constexpr int MH = 32, DQK = 192, DVV = 128;
constexpr int UQ_N = MH * DQK;
constexpr int UKV_N = MH * 256;
constexpr int NG = 4, HPG = 8, NH = 32;
constexpr int SB_N = 10240;
constexpr int SB_K0 = 0, SB_V0 = 2304, SB_Q0 = 3840, SB_G0 = 9984;
constexpr int NCMP_PAD = 128;
constexpr float NORM_EPS = 1e-6f;
constexpr float QSCALE = 0.07216878364870322f * 1.4426950408889634f;
constexpr int NWAVES = 8;
constexpr int FFN_Q8_LAYER = 1;
#ifndef MK_ONE_LAUNCH
#define MK_ONE_LAUNCH 0
#endif

constexpr size_t MiB = 1u << 20;
constexpr size_t alignup(size_t x) { return (x + (MiB - 1)) & ~(MiB - 1); }
constexpr size_t WS_CTL = 0, CTL_ZERO_BYTES = 1 * MiB;
constexpr size_t WS_WA   = 1 * MiB;
constexpr size_t WS_WUQ  = WS_WA   + alignup((size_t)A_IN_PAD * DM * 2);
constexpr size_t WS_WUKV = WS_WUQ  + alignup((size_t)UQ_N * QL * 2);
constexpr size_t WS_WOA  = WS_WUKV + alignup((size_t)UKV_N * KVL * 2);
constexpr size_t WS_WFI  = WS_WOA  + alignup((size_t)DM * DM * 2);
constexpr size_t WFI_STRIDE = alignup((size_t)2 * FF * DM * 2);
constexpr size_t WS_WFO  = WS_WFI  + 2 * WFI_STRIDE;
constexpr size_t WFO_STRIDE = alignup((size_t)DM * FF * 2);
constexpr size_t WS_WSB  = WS_WFO  + 2 * WFO_STRIDE;
constexpr size_t WS_WOB  = WS_WSB  + alignup((size_t)SB_N * DM * 2);
constexpr size_t WS_W1K  = WS_WOB  + alignup((size_t)DM * DM * 2);
constexpr size_t WS_W2K  = WS_W1K  + alignup((size_t)192 * 6144 * 2);
constexpr size_t WS_W1V  = WS_W2K  + MiB;
constexpr size_t WS_W2V  = WS_W1V  + alignup((size_t)128 * 4096 * 2);
constexpr size_t WS_BIAS = WS_W2V  + MiB;
constexpr size_t WS_TABA = WS_BIAS + MiB;
constexpr size_t WS_TABB = WS_TABA + alignup((size_t)M * 32 * 8);
constexpr size_t WS_XN   = WS_TABB + alignup((size_t)M * 96 * 8);
constexpr size_t WS_UA   = WS_XN   + alignup((size_t)M * DM * 2);
constexpr size_t WS_CQ   = WS_UA   + alignup((size_t)M * A_IN_PAD * 4);
constexpr size_t WS_CKV  = WS_CQ   + alignup((size_t)M * QL * 2);
constexpr size_t WS_QA   = WS_CKV  + alignup((size_t)M * KVL * 2);
constexpr size_t WS_KA   = WS_QA   + alignup((size_t)M * UQ_N * 2);
constexpr size_t WS_VA   = WS_KA   + alignup((size_t)M * MH * DQK * 2);
constexpr size_t WS_OA   = WS_VA   + alignup((size_t)M * MH * DVV * 2);
constexpr size_t WS_H    = WS_OA   + alignup((size_t)M * DM * 2);
constexpr size_t WS_ACT  = WS_H    + alignup((size_t)M * DM * 4);
constexpr size_t WS_KB   = WS_ACT  + alignup((size_t)M * FF * 2);
constexpr size_t KB_BR   = (size_t)NB * NG * SEQ * DQK;
constexpr size_t WS_VB   = WS_KB   + alignup(3 * KB_BR * 2 + MiB);
constexpr size_t VB_BR   = (size_t)NB * NG * SEQ * DVV;
constexpr size_t WS_GATE = WS_VB   + alignup(3 * VB_BR * 2 + MiB);
constexpr size_t WS_HIDK = WS_GATE + alignup((size_t)M * 96 * 4);
constexpr size_t WS_HIDV = WS_HIDK + MiB;
constexpr size_t WS_KC   = WS_HIDV + MiB;
constexpr size_t WS_VC   = WS_KC   + MiB;
constexpr size_t WS_SEL  = WS_VC   + MiB;
constexpr size_t WS_OC   = WS_SEL  + MiB;
constexpr size_t WS_OS   = WS_OC   + alignup((size_t)M * DM * 4);
constexpr size_t WS_H2   = WS_OS   + alignup((size_t)M * DM * 4);
constexpr size_t WS_XN8  = WS_H2   + alignup((size_t)M * DM * 4);
constexpr size_t WS_SA   = WS_XN8  + alignup((size_t)M * DM);
constexpr size_t WS_END  = WS_SA   + MiB;

constexpr int CM_FFI = 10240, CM_WOA = 32256, CM_WOB = 36352, CM_WUQ = 40448, CM_WUKV = 46592;
constexpr int CW_TMO = 0, CW_CODE = 1, CW_BAR = 4096, CW_NSAQ = 8192, CW_CMAX = 16384;

constexpr int RING_OFF = 0, RING_BYTES = 131072;
constexpr int LDSCTL_OFF = RING_BYTES, MISC_OFF = LDSCTL_OFF + 320;
constexpr int LDS_BYTES = 147456;
constexpr int ATT_K = 0, ATT_K2 = 24576, ATT_V = 49152, ATT_WS = 81920, ATT_IMP = 83968, ATT_SC = 116736, ATT_SELW = 120832;
typedef float f32x16 __attribute__((ext_vector_type(16)));
typedef float f32x2 __attribute__((ext_vector_type(2)));
typedef short s16x4 __attribute__((ext_vector_type(4)));
typedef unsigned long long u64;

__device__ __forceinline__ unsigned cvtpk(float lo, float hi) { unsigned r; asm volatile("v_cvt_pk_bf16_f32 %0, %1, %2" : "=v"(r) : "v"(lo), "v"(hi)); return r; }
__device__ __forceinline__ v4u pk8(f32x4 a, f32x4 b) { v4u w; w.x = cvtpk(a[0], a[1]); w.y = cvtpk(a[2], a[3]); w.z = cvtpk(b[0], b[1]); w.w = cvtpk(b[2], b[3]); return w; }
__device__ __forceinline__ float bf2f(bf16 b) { return __builtin_bit_cast(float, (unsigned)b << 16); }
__device__ __forceinline__ float fast_exp2(float x) { return __builtin_amdgcn_exp2f(x); }
__device__ __forceinline__ float sigmoidf_(float x) { return 1.f / (1.f + __expf(-x)); }
__device__ __forceinline__ float gelu_tanh(float x) { const float z = 0.7978845608028654f * (x + 0.044715f * x * x * x); return x / (1.f + __expf(-2.f * z)); }
__device__ __forceinline__ int crow(int r, int hi) { return (r & 3) + 8 * (r >> 2) + 4 * hi; }
#define SBAR() __builtin_amdgcn_sched_barrier(0)
template <int K> __device__ __forceinline__ float swz_xor(float v) { return __builtin_bit_cast(float, __builtin_amdgcn_ds_swizzle(__builtin_bit_cast(int, v), 0x1F | (K << 10))); }
__device__ __forceinline__ float half_max(float v) { auto rr = __builtin_amdgcn_permlane32_swap(__float_as_uint(v), __float_as_uint(v), false, false); return fmaxf(__uint_as_float(rr[0]), __uint_as_float(rr[1])); }
__device__ __forceinline__ float half_sum(float v) { auto rr = __builtin_amdgcn_permlane32_swap(__float_as_uint(v), __float_as_uint(v), false, false); return __uint_as_float(rr[0]) + __uint_as_float(rr[1]); }

__device__ __forceinline__ float wave_sum(float v) { v += swz_xor<1>(v); v += swz_xor<2>(v); v += swz_xor<4>(v); v += swz_xor<8>(v); v += swz_xor<16>(v); return half_sum(v); }
template <int K> __device__ __forceinline__ unsigned swz_xor_u(unsigned v) { return (unsigned)__builtin_amdgcn_ds_swizzle((int)v, 0x1F | (K << 10)); }

struct Frame {
    LAS unsigned char* lds;
    volatile LAS unsigned* MISC;
    gu32* ctl;
    int tid, lane, wave;
    int vcu, G;
    unsigned char* ws;
};

__device__ __forceinline__ int fresh_lane() { unsigned z; asm volatile("v_mov_b32 %0, 0" : "=v"(z)); return (int)__builtin_amdgcn_mbcnt_hi(~0u, __builtin_amdgcn_mbcnt_lo(~0u, z)); }
__device__ __forceinline__ int fresh_tid(int wave) { return wave * 64 + fresh_lane(); }
__device__ __forceinline__ void frame_fresh(Frame& F) { const int t = fresh_tid(F.wave); F.tid = t; F.lane = t & 63; }
template <class CM, class RM>
__device__ __forceinline__ void conv_item(const float* __restrict__ W, int Nsrc, const float* __restrict__ gain, bf16* WT, int K, int row_off, int nblk, LAS float* scr, int item, int lane, const CM& cm, const RM& rm) {
    const int kb = item / nblk, nb = item - kb * nblk, k0 = 64 * kb, n0 = 32 * nb;
    const int sc = cm(n0 + (lane & 31));
#pragma unroll 8
    for (int i = 0; i < 32; ++i) { const int kk = 2 * i + (lane >> 5); const int sr = rm(k0 + kk);
        float v = 0.f; if (sc >= 0) { v = W[(size_t)sr * Nsrc + sc]; if (gain) v *= gain[sr]; }
        scr[kk * 33 + (lane & 31)] = v; }
    LDS_WAIT(); asm volatile("" ::: "memory");
    const int c = lane & 7;
#pragma unroll
    for (int j = 0; j < 4; ++j) { const int n = (lane >> 3) + 8 * j; const LAS float* s = scr + (8 * c) * 33 + n;
        v4u o; o.x = pk2(s[0 * 33], s[1 * 33]); o.y = pk2(s[2 * 33], s[3 * 33]); o.z = pk2(s[4 * 33], s[5 * 33]); o.w = pk2(s[6 * 33], s[7 * 33]);
        *(GAS v4u*)(WT + (size_t)(row_off + n0 + n) * K + k0 + 8 * c) = o; }
    LDS_WAIT(); asm volatile("" ::: "memory");
}
template <class CM, class RM>
__device__ __forceinline__ void conv_matrix(Frame& F, const float* W, int Nsrc, const float* gain, bf16* WT, int K, int Ndst, int row_off, const CM& cm, const RM& rm) {
    LAS float* scr = (LAS float*)(F.lds + RING_OFF + F.wave * 8448);
    const int gw = F.vcu * NWAVES + F.wave, NGW = F.G * NWAVES;
    const int nblk = Ndst / 32, nitems = (K / 64) * nblk;
    for (int it = gw; it < nitems; it += NGW) conv_item(W, Nsrc, gain, WT, K, row_off, nblk, scr, it, F.lane, cm, rm);
}
__device__ __forceinline__ size_t wt_off(int n, int k, int K) { return ((size_t)(n >> 8) * (K >> 6) + (k >> 6)) * 16384 + (size_t)((n & 255) * 64 + (k & 63)); }
template <class IM>
__device__ __forceinline__ void conv_fast(Frame& F, const float* __restrict__ W, int Ksrc, int Nsrc, const float* __restrict__ gain, bf16* WT, int row_off, const IM& im) {
    LAS unsigned* scr = (LAS unsigned*)(F.lds + RING_OFF + F.wave * 8448);
    const int gw = F.vcu * NWAVES + F.wave, NGW = F.G * NWAVES, lane = F.lane;
    const int ncb = (Nsrc + 63) / 64, nitems = (Ksrc / 64) * ncb;
    const int q = lane & 15, r4 = lane >> 4;
    for (int it = gw; it < nitems; it += NGW) {
        const int nkb = Ksrc / 64, cb = it / nkb, kb = it - cb * nkb, k0 = 64 * kb, c0 = 64 * cb;
        const bool cok = c0 + 4 * q < Nsrc;
        f32x4 v[16];
        const GAS char* base = (const GAS char*)W + ((size_t)k0 * Nsrc + c0) * 4;
        const unsigned lo = ((unsigned)(2 * r4) * (unsigned)Nsrc + 4u * q) * 4u;
#pragma unroll
        for (int i = 0; i < 8; ++i) {
#pragma unroll
            for (int e = 0; e < 2; ++e) v[2 * i + e] = cok ? __builtin_nontemporal_load((const GAS f32x4*)(base + lo + (unsigned)((8 * i + e) * Nsrc) * 4u)) : (f32x4){0.f, 0.f, 0.f, 0.f}; }
#pragma unroll
        for (int i = 0; i < 8; ++i) { const int kr = k0 + 8 * i + 2 * r4; float g0 = 1.f, g1 = 1.f; if (gain) { g0 = gain[kr]; g1 = gain[kr + 1]; }
            const f32x4 a = v[2 * i] * g0, b = v[2 * i + 1] * g1; const int kp = 4 * i + r4;
#pragma unroll
            for (int j = 0; j < 4; ++j) scr[(4 * q + j) * 33 + kp] = cvtpk(a[j], b[j]); }
        LDS_WAIT(); asm volatile("" ::: "memory");
        const int ch = lane & 7;
#pragma unroll
        for (int jj = 0; jj < 8; ++jj) { const int c = (lane >> 3) + 8 * jj; const LAS unsigned* sp = scr + c * 33 + 4 * ch;
            v4u o; o.x = sp[0]; o.y = sp[1]; o.z = sp[2]; o.w = sp[3];
            const int n = (c0 + c < Nsrc) ? im(c0 + c) : -1;
            if (n >= 0) __builtin_nontemporal_store(o, (GAS v4u*)(WT + wt_off(row_off + n, k0 + 8 * ch, Ksrc))); }
        LDS_WAIT(); asm volatile("" ::: "memory");
    }
}
__device__ __forceinline__ void zero_rows(Frame& F, bf16* WT, int K, int r0, int r1) {
    const int kc = K / 8, n16 = (r1 - r0) * kc;
    for (int i = F.vcu * NWAVES * 64 + F.tid; i < n16; i += F.G * NWAVES * 64) { const int n = r0 + i / kc, c = i - (i / kc) * kc; *(GAS v4u*)(WT + wt_off(n, 8 * c, K)) = (v4u){0u, 0u, 0u, 0u}; }
}
struct InvUq { __device__ __forceinline__ int operator()(int c) const { const int h = c / 192, d = c - h * 192; const int dp = d < 128 ? d : 128 + 2 * ((d - 128) & 31) + ((d - 128) >> 5); return h * 192 + dp; } };
struct InvFfi { __device__ __forceinline__ int operator()(int c) const { const int p = c >= FF ? 1 : 0, cc = c - p * FF; return 256 * (cc >> 7) + 128 * p + (cc & 127); } };
__device__ __forceinline__ int nsa_dp(int d) { return d < 96 ? 2 * d : 2 * (d - 96) + 1; }
struct InvSkv { __device__ __forceinline__ int operator()(int c) const { const int kh = c / 320, e = c - kh * 320; return e < 192 ? kh * 192 + nsa_dp(e) : SB_V0 + kh * 128 + (e - 192); } };
struct InvBin { __device__ __forceinline__ int operator()(int c) const { if (c >= 6144) return c; const int h = c / 192, d = c - h * 192; return h * 192 + nsa_dp(d); } };
struct MapId { __device__ __forceinline__ int operator()(int n) const { return n; } };
struct MapLim { int lim; __device__ __forceinline__ int operator()(int n) const { return n < lim ? n : -1; } };
struct MapUq { __device__ __forceinline__ int operator()(int n) const { const int h = n / 192, dp = n - h * 192; const int d = dp < 128 ? dp : 128 + ((dp - 128) >> 1) + 32 * ((dp - 128) & 1); return h * 192 + d; } };
struct MapFfi { __device__ __forceinline__ int operator()(int n) const { const int t = n >> 8, p = (n >> 7) & 1, j = n & 127; return p * FF + 128 * t + j; } };
__device__ __forceinline__ int nsa_d(int dp) { return (dp >> 1) + 96 * (dp & 1); }
struct MapSkv { __device__ __forceinline__ int operator()(int n) const {
        if (n < SB_V0) { const int kh = n / 192, dp = n - kh * 192; return kh * 320 + nsa_d(dp); }
        const int c2 = n - SB_V0, kh = c2 >> 7, dv = c2 & 127; return kh * 320 + 192 + dv; } };
struct MapBin { __device__ __forceinline__ int operator()(int n) const {
        if (n < 6144) { const int h = n / 192, dp = n - h * 192; return h * 192 + nsa_d(dp); }
        return n < 6240 ? n : -1; } };
struct MapW1kRow { __device__ __forceinline__ int operator()(int k) const { const int l = k / 192, dp = k - l * 192; return l * 192 + nsa_d(dp); } };
struct MapW2kCol { __device__ __forceinline__ int operator()(int n) const { return nsa_d(n); } };

__device__ __forceinline__ u64 pack4(f32x4 v) { return (u64)cvtpk(v[0], v[1]) | ((u64)cvtpk(v[2], v[3]) << 32); }
__device__ __forceinline__ void norm_row_bf16(const float* xrow, bf16* orow, int lane) {
    const GAS f32x4* xr = (const GAS f32x4*)xrow + lane;
    f32x4 v[16]; float s = 0.f;
#pragma unroll
    for (int j = 0; j < 16; ++j) { v[j] = xr[64 * j]; s += (v[j].x * v[j].x + v[j].y * v[j].y) + (v[j].z * v[j].z + v[j].w * v[j].w); }
    const float r = 1.f / sqrtf(wave_sum(s) * (1.f / DM) + NORM_EPS);
    GAS u64* o8 = (GAS u64*)orow + lane;
#pragma unroll
    for (int j = 0; j < 16; ++j) o8[64 * j] = pack4(v[j] * r);
}
__device__ __forceinline__ void norm_phase(Frame& F, const float* X, bf16* XN) {
    const int gw = F.vcu * NWAVES + F.wave, NGW = F.G * NWAVES;
    for (int m = gw; m < M; m += NGW) norm_row_bf16(X + (size_t)m * DM, XN + (size_t)m * DM, F.lane);
}
__device__ __forceinline__ size_t wt8_off(int n, int k, int K) { return ((size_t)(n >> 8) * (K >> 7) + (k >> 7)) * 32768 + (size_t)((n & 255) * 128 + (k & 127)); }
template <class IM>
__device__ __forceinline__ void conv_colmax(Frame& F, const float* __restrict__ W, int Ksrc, int Nsrc, const float* __restrict__ gain, gu32* CMAX, int row_off, const IM& im) {
    const int gw = F.vcu * NWAVES + F.wave, NGW = F.G * NWAVES, lane = F.lane;
    const int ncb = (Nsrc + 63) / 64, nkb = Ksrc / 64, nitems = nkb * ncb;
    const int q = lane & 15, r4 = lane >> 4;
    for (int it = gw; it < nitems; it += NGW) {
        const int cb = it / nkb, kb = it - cb * nkb, k0 = 64 * kb, c0 = 64 * cb;
        const bool cok = c0 + 4 * q < Nsrc;
        const GAS char* base = (const GAS char*)W + ((size_t)k0 * Nsrc + c0) * 4;
        const unsigned lo = ((unsigned)(4 * r4) * (unsigned)Nsrc + 4u * q) * 4u;
        f32x4 v[16];
#pragma unroll
        for (int i = 0; i < 4; ++i)
#pragma unroll
            for (int e = 0; e < 4; ++e) v[4 * i + e] = cok ? __builtin_nontemporal_load((const GAS f32x4*)(base + lo + (unsigned)((16 * i + e) * Nsrc) * 4u)) : (f32x4){0.f, 0.f, 0.f, 0.f};
        f32x4 mx = {0.f, 0.f, 0.f, 0.f};
#pragma unroll
        for (int i = 0; i < 4; ++i)
#pragma unroll
            for (int e = 0; e < 4; ++e) { const float g = gain ? gain[k0 + 16 * i + 4 * r4 + e] : 1.f;
#pragma unroll
                for (int j = 0; j < 4; ++j) mx[j] = fmaxf(mx[j], fabsf(v[4 * i + e][j] * g)); }
#pragma unroll
        for (int j = 0; j < 4; ++j) { float m = mx[j]; m = fmaxf(m, swz_xor<16>(m)); m = half_max(m);
            const int c = c0 + 4 * q + j; const int n = (c < Nsrc) ? im(c) : -1;
            if (r4 == 0 && n >= 0) __hip_atomic_fetch_max(CMAX + row_off + n, __float_as_uint(m), __ATOMIC_RELAXED, __HIP_MEMORY_SCOPE_AGENT); }
    }
}
template <class IM>
__device__ __forceinline__ void conv_fast_q8(Frame& F, const float* __restrict__ W, int Ksrc, int Nsrc, const float* __restrict__ gain, signed char* WT8, const gu32* CMAX, int row_off, const IM& im) {
    LAS unsigned* scr = (LAS unsigned*)(F.lds + RING_OFF + F.wave * 8448);
    const int gw = F.vcu * NWAVES + F.wave, NGW = F.G * NWAVES, lane = F.lane;
    const int ncb = (Nsrc + 63) / 64, nkb = Ksrc / 64, nitems = nkb * ncb;
    const int q = lane & 15, r4 = lane >> 4;
    for (int it = gw; it < nitems; it += NGW) {
        const int cb = it / nkb, kb = it - cb * nkb, k0 = 64 * kb, c0 = 64 * cb;
        const bool cok = c0 + 4 * q < Nsrc;
        const GAS char* base = (const GAS char*)W + ((size_t)k0 * Nsrc + c0) * 4;
        const unsigned lo = ((unsigned)(4 * r4) * (unsigned)Nsrc + 4u * q) * 4u;
        f32x4 v[16];
#pragma unroll
        for (int i = 0; i < 4; ++i)
#pragma unroll
            for (int e = 0; e < 4; ++e) v[4 * i + e] = cok ? __builtin_nontemporal_load((const GAS f32x4*)(base + lo + (unsigned)((16 * i + e) * Nsrc) * 4u)) : (f32x4){0.f, 0.f, 0.f, 0.f};
        f32x4 qs;
#pragma unroll
        for (int j = 0; j < 4; ++j) { const int c = c0 + 4 * q + j; const int n = (c < Nsrc) ? im(c) : -1; const float cm = n >= 0 ? __uint_as_float(__hip_atomic_load(CMAX + row_off + n, __ATOMIC_RELAXED, __HIP_MEMORY_SCOPE_AGENT)) : 0.f; qs[j] = cm > 0.f ? 127.f / cm : 0.f; }
#pragma unroll
        for (int i = 0; i < 4; ++i) { unsigned pk[4] = {0u, 0u, 0u, 0u};
#pragma unroll
            for (int e = 0; e < 4; ++e) { const float g = gain ? gain[k0 + 16 * i + 4 * r4 + e] : 1.f;
#pragma unroll
                for (int j = 0; j < 4; ++j) { const int qi = (int)rintf(v[4 * i + e][j] * g * qs[j]); pk[j] |= ((unsigned)qi & 0xffu) << (8 * e); } }
#pragma unroll
            for (int j = 0; j < 4; ++j) scr[(4 * q + j) * 17 + 4 * i + r4] = pk[j]; }
        LDS_WAIT(); asm volatile("" ::: "memory");
        const int ch = lane & 3;
#pragma unroll
        for (int jj = 0; jj < 4; ++jj) { const int c = (lane >> 2) + 16 * jj; const LAS unsigned* sp = scr + c * 17 + 4 * ch;
            v4u o; o.x = sp[0]; o.y = sp[1]; o.z = sp[2]; o.w = sp[3];
            const int n = (c0 + c < Nsrc) ? im(c0 + c) : -1;
            if (n >= 0) *(GAS v4u*)((GAS char*)WT8 + wt8_off(row_off + n, k0 + 16 * ch, Ksrc)) = o; }
        LDS_WAIT(); asm volatile("" ::: "memory");
    }
}
__device__ __forceinline__ void zero_rows8(Frame& F, signed char* WT8, int K, int r0, int r1) {
    const int kc = K / 16, n16 = (r1 - r0) * kc;
    for (int i = F.vcu * NWAVES * 64 + F.tid; i < n16; i += F.G * NWAVES * 64) { const int n = r0 + i / kc, c = i - (i / kc) * kc; *(GAS v4u*)((GAS char*)WT8 + wt8_off(n, 16 * c, K)) = (v4u){0u, 0u, 0u, 0u}; }
}
__device__ __forceinline__ void norm_phase_q8(Frame& F, const float* X, signed char* XN8, float* SA) {
    const int gw = F.vcu * NWAVES + F.wave, NGW = F.G * NWAVES;
    for (int m = gw; m < M; m += NGW) {
        const GAS f32x4* xr = (const GAS f32x4*)(X + (size_t)m * DM) + F.lane;
        f32x4 v[16]; float s = 0.f, am = 0.f;
#pragma unroll
        for (int j = 0; j < 16; ++j) { v[j] = xr[64 * j]; s += (v[j].x * v[j].x + v[j].y * v[j].y) + (v[j].z * v[j].z + v[j].w * v[j].w);
            am = fmaxf(am, fmaxf(fmaxf(fabsf(v[j].x), fabsf(v[j].y)), fmaxf(fabsf(v[j].z), fabsf(v[j].w)))); }
        const float r = 1.f / sqrtf(wave_sum(s) * (1.f / DM) + NORM_EPS);
        am = fmaxf(am, swz_xor<1>(am)); am = fmaxf(am, swz_xor<2>(am)); am = fmaxf(am, swz_xor<4>(am)); am = fmaxf(am, swz_xor<8>(am)); am = fmaxf(am, swz_xor<16>(am)); am = half_max(am);
        const float qs = am > 0.f ? 127.f / am : 0.f;
        if (F.lane == 0) SA[m] = am * r * (1.f / 127.f);
        GAS unsigned* o4 = (GAS unsigned*)(XN8 + (size_t)m * DM) + F.lane;
#pragma unroll
        for (int j = 0; j < 16; ++j) { const int a = (int)rintf(v[j].x * qs), b = (int)rintf(v[j].y * qs), c = (int)rintf(v[j].z * qs), d = (int)rintf(v[j].w * qs);
            o4[64 * j] = ((unsigned)a & 0xffu) | (((unsigned)b & 0xffu) << 8) | (((unsigned)c & 0xffu) << 16) | (((unsigned)d & 0xffu) << 24); }
    }
}
__device__ __forceinline__ void quant_rows_phase(Frame& F, const bf16* X, signed char* Q8, float* SA) {
    const int gw = F.vcu * NWAVES + F.wave, NGW = F.G * NWAVES;
    for (int m = gw; m < M; m += NGW) {
        const GAS v4u* xr = (const GAS v4u*)(X + (size_t)m * DM) + F.lane;
        v4u w[8]; float am = 0.f;
#pragma unroll
        for (int j = 0; j < 8; ++j) w[j] = xr[64 * j];
#pragma unroll
        for (int j = 0; j < 8; ++j) {
#pragma unroll
            for (int e = 0; e < 4; ++e) { const unsigned u = w[j][e]; am = fmaxf(am, fmaxf(fabsf(__uint_as_float(u << 16)), fabsf(__uint_as_float(u & 0xffff0000u)))); } }
        am = fmaxf(am, swz_xor<1>(am)); am = fmaxf(am, swz_xor<2>(am)); am = fmaxf(am, swz_xor<4>(am)); am = fmaxf(am, swz_xor<8>(am)); am = fmaxf(am, swz_xor<16>(am)); am = half_max(am);
        const float qs = am > 0.f ? 127.f / am : 0.f;
        if (F.lane == 0) SA[m] = am * (1.f / 127.f);
        GAS u64* o8 = (GAS u64*)(Q8 + (size_t)m * DM) + F.lane;
#pragma unroll
        for (int j = 0; j < 8; ++j) { u64 o = 0;
#pragma unroll
            for (int e = 0; e < 4; ++e) { const unsigned u = w[j][e]; const int a = (int)rintf(__uint_as_float(u << 16) * qs), b = (int)rintf(__uint_as_float(u & 0xffff0000u) * qs);
                o |= (u64)(((unsigned)a & 0xffu) | (((unsigned)b & 0xffu) << 8)) << (16 * e); }
            o8[64 * j] = o; }
    }
}
__device__ __forceinline__ void final_norm_phase(Frame& F, const float* X, const float* g, float* out) {
    const int gw = F.vcu * NWAVES + F.wave, NGW = F.G * NWAVES;
    for (int m = gw; m < M; m += NGW) {
        const GAS f32x4* xr = (const GAS f32x4*)(X + (size_t)m * DM) + F.lane; const GAS f32x4* gr = (const GAS f32x4*)g + F.lane;
        f32x4 v[16]; float s = 0.f;
#pragma unroll
        for (int j = 0; j < 16; ++j) { v[j] = xr[64 * j]; s += (v[j].x * v[j].x + v[j].y * v[j].y) + (v[j].z * v[j].z + v[j].w * v[j].w); }
        const float r = 1.f / sqrtf(wave_sum(s) * (1.f / DM) + NORM_EPS);
        GAS f32x4* o = (GAS f32x4*)(out + (size_t)m * DM) + F.lane;
#pragma unroll
        for (int j = 0; j < 16; ++j) o[64 * j] = v[j] * r * gr[64 * j];
    }
}
__device__ __forceinline__ void rope_tables(Frame& F, const int* pos, f32x2* tabA, f32x2* tabB) {
    const int gt = F.vcu * NWAVES * 64 + F.tid, NT = F.G * NWAVES * 64;
    for (int e = gt; e < M * 128; e += NT) {
        const int tok = e >> 7, j = e & 127;
        const bool isA = j < 32; const int i = isA ? j : j - 32; const float d = isA ? 64.f : 192.f;
        const float inv = powf(10000.f, -(float)(2 * i) / d);
        const float ang = (float)pos[tok] * inv;
        const double rev = (double)ang * 0.15915494309189535; const float fr = (float)(rev - floor(rev));
        f32x2 cs; cs.x = __builtin_amdgcn_cosf(fr); cs.y = __builtin_amdgcn_sinf(fr);
        if (isA) tabA[(size_t)tok * 32 + i] = cs; else tabB[(size_t)tok * 96 + i] = cs;
    }
}
__device__ __forceinline__ void pe_bias(Frame& F, const float* pe, const float* W1, int K, int N, float* bias) {
    const int gw = F.vcu * NWAVES + F.wave, NGW = F.G * NWAVES;
    for (int n = NGW - 1 - gw; n < N; n += NGW) {
        float s = 0.f;
        for (int k0 = F.lane; k0 < K; k0 += 64 * 16) { float w[16], p[16];
#pragma unroll
            for (int u = 0; u < 16; ++u) { const int k = k0 + 64 * u; const bool ok = k < K; w[u] = ok ? W1[(size_t)k * N + n] : 0.f; p[u] = ok ? pe[k] : 0.f; }
#pragma unroll
            for (int u = 0; u < 16; ++u) s += p[u] * w[u]; }
        s = wave_sum(s); if (F.lane == 0) bias[n] = s; }
}
__device__ __forceinline__ unsigned q8x4(f32x4 v, float qs) { const int a = (int)rintf(v.x * qs), b = (int)rintf(v.y * qs), c = (int)rintf(v.z * qs), d = (int)rintf(v.w * qs);
    return ((unsigned)a & 0xffu) | (((unsigned)b & 0xffu) << 8) | (((unsigned)c & 0xffu) << 16) | (((unsigned)d & 0xffu) << 24); }
__device__ __forceinline__ float wave_max(float v) { v = fmaxf(v, swz_xor<1>(v)); v = fmaxf(v, swz_xor<2>(v)); v = fmaxf(v, swz_xor<4>(v)); v = fmaxf(v, swz_xor<8>(v)); v = fmaxf(v, swz_xor<16>(v)); return half_max(v); }
__device__ __forceinline__ float amax4(f32x4 v) { return fmaxf(fmaxf(fabsf(v.x), fabsf(v.y)), fmaxf(fabsf(v.z), fabsf(v.w))); }
__device__ __forceinline__ void mla_latent_phase(Frame& F, const float* UA, signed char* CQ8, signed char* CKV8, float* SAq, float* SAkv, bf16* KA, const f32x2* tabA) {
    const int gw = F.vcu * NWAVES + F.wave, NGW = F.G * NWAVES; const int lane = F.lane;
    for (int m = gw; m < M; m += NGW) {
        const float* u = UA + (size_t)m * A_IN_PAD;
        const GAS f32x4* uq = (const GAS f32x4*)u + lane; const GAS f32x4* uk = (const GAS f32x4*)(u + QL) + lane;
        const int i = lane & 31;
        f32x4 q[6], kv[2];
#pragma unroll
        for (int j = 0; j < 6; ++j) q[j] = uq[64 * j];
#pragma unroll
        for (int j = 0; j < 2; ++j) kv[j] = uk[64 * j];
        const float x1 = u[QL + KVL + i], x2 = u[QL + KVL + 32 + i]; const f32x2 cs = tabA[(size_t)m * 32 + i];
        float s = 0.f, s2 = 0.f, aq = 0.f, ak = 0.f;
#pragma unroll
        for (int j = 0; j < 6; ++j) { s += (q[j].x * q[j].x + q[j].y * q[j].y) + (q[j].z * q[j].z + q[j].w * q[j].w); aq = fmaxf(aq, amax4(q[j])); }
#pragma unroll
        for (int j = 0; j < 2; ++j) { s2 += (kv[j].x * kv[j].x + kv[j].y * kv[j].y) + (kv[j].z * kv[j].z + kv[j].w * kv[j].w); ak = fmaxf(ak, amax4(kv[j])); }
        const float rq = 1.f / sqrtf(wave_sum(s) * (1.f / QL) + NORM_EPS), rk = 1.f / sqrtf(wave_sum(s2) * (1.f / KVL) + NORM_EPS);
        aq = wave_max(aq); ak = wave_max(ak);
        const float qsq = aq > 0.f ? 127.f / aq : 0.f, qsk = ak > 0.f ? 127.f / ak : 0.f;
        if (lane == 0) { SAq[m] = aq * rq * (1.f / 127.f); SAkv[m] = ak * rk * (1.f / 127.f); }
        GAS unsigned* oq = (GAS unsigned*)(CQ8 + (size_t)m * QL) + lane;
#pragma unroll
        for (int j = 0; j < 6; ++j) oq[64 * j] = q8x4(q[j], qsq);
        GAS unsigned* ok = (GAS unsigned*)(CKV8 + (size_t)m * KVL) + lane;
#pragma unroll
        for (int j = 0; j < 2; ++j) ok[64 * j] = q8x4(kv[j], qsk);
        const unsigned pk = cvtpk(x1 * cs.x - x2 * cs.y, x2 * cs.x + x1 * cs.y);
        const int b = m >> 11, sq = m & 2047, h0 = (lane >> 5) * 16;
#pragma unroll 4
        for (int h = 0; h < 16; ++h) *(GAS unsigned*)(KA + ((size_t)((b * MH + h0 + h) * SEQ + sq)) * DQK + 128 + 2 * i) = pk;
    }
}
template <class Fn> struct EpiRow8 {
    static constexpr bool PERM = true, AFTER_DRAIN = false; Fn f;
    __device__ __forceinline__ void operator()(const pg8::f32x4 (&acc)[2][2][4][2], const pg8::Unit& u, int wr, int wc, int fr, int fq) const {
        const int row0 = u.pm * 256 + wr * 64 + fr, col0 = u.pn * 256 + wc * 32 + 8 * fq;
#pragma unroll
        for (int ai = 0; ai < 2; ++ai)
#pragma unroll
            for (int m = 0; m < 4; ++m)
#pragma unroll
                for (int bj = 0; bj < 2; ++bj) f(row0 + ai * 128 + m * 16, col0 + bj * 128, acc[ai][bj][m][0], acc[ai][bj][m][1]);
    }
};
template <class Fn> struct EpiGate {
    static constexpr bool PERM = true, AFTER_DRAIN = false; Fn f;
    __device__ __forceinline__ void operator()(const pg8::f32x4 (&acc)[2][2][4][2], const pg8::Unit& u, int wr, int wc, int fr, int fq) const {
        const int row0 = u.pm * 256 + wr * 64 + fr, col0 = u.pn * 128 + wc * 32 + 8 * fq;
#pragma unroll
        for (int ai = 0; ai < 2; ++ai)
#pragma unroll
            for (int m = 0; m < 4; ++m) f(row0 + ai * 128 + m * 16, col0, acc[ai][0][m][0], acc[ai][0][m][1], acc[ai][1][m][0], acc[ai][1][m][1]);
    }
};
__device__ __forceinline__ void rope4r(f32x4& v0, f32x4& v1, const f32x4 t0, const f32x4 t1) {
    f32x4 a, b;
    a.x = v0.x * t0.x - v0.y * t0.y; a.y = v0.y * t0.x + v0.x * t0.y; a.z = v0.z * t0.z - v0.w * t0.w; a.w = v0.w * t0.z + v0.z * t0.w;
    b.x = v1.x * t1.x - v1.y * t1.y; b.y = v1.y * t1.x + v1.x * t1.y; b.z = v1.z * t1.z - v1.w * t1.w; b.w = v1.w * t1.z + v1.z * t1.w;
    v0 = a; v1 = b;
}
__device__ __forceinline__ void rope4(f32x4& v0, f32x4& v1, const f32x2* t) {
    const f32x4 t0 = *(const GAS f32x4*)t, t1 = *(const GAS f32x4*)(t + 2);
    f32x4 a, b;
    a.x = v0.x * t0.x - v0.y * t0.y; a.y = v0.y * t0.x + v0.x * t0.y; a.z = v0.z * t0.z - v0.w * t0.w; a.w = v0.w * t0.z + v0.z * t0.w;
    b.x = v1.x * t1.x - v1.y * t1.y; b.y = v1.y * t1.x + v1.x * t1.y; b.z = v1.z * t1.z - v1.w * t1.w; b.w = v1.w * t1.z + v1.z * t1.w;
    v0 = a; v1 = b;
}
#define GOFF(T, base, byteoff) (*(GAS T*)((GAS char*)(base) + (byteoff)))
struct FnUA { float* UA; __device__ __forceinline__ void operator()(int row, int col, f32x4 v0, f32x4 v1) const {
        if (col < A_IN) { const unsigned o = ((unsigned)row * A_IN_PAD + col) * 4u; GOFF(f32x4, UA, o) = v0; GOFF(f32x4, UA, o + 16u) = v1; } } };
struct FnQa { bf16* QA; const f32x2* tab; __device__ __forceinline__ void operator()(int row, int col, f32x4 v0, f32x4 v1) const {
        const int h = col / 192, d = col - h * 192;
        if (d >= 128) { const unsigned to = ((unsigned)row * 32 + ((d - 128) >> 1)) * 8u; rope4(v0, v1, (const f32x2*)((const GAS char*)tab + to)); }
        GOFF(v4u, QA, ((unsigned)row * UQ_N + col) * 2u) = pk8(v0 * QSCALE, v1 * QSCALE); } };
struct FnKVa { bf16* KA; bf16* VA; __device__ __forceinline__ void operator()(int row, int col, f32x4 v0, f32x4 v1) const {
        const int h = col >> 8, j = col & 255, b = row >> 11, s = row & 2047; const unsigned r = (unsigned)(b * MH + h) * SEQ + s;
        if (j < 128) GOFF(v4u, KA, (r * DQK + j) * 2u) = pk8(v0, v1); else GOFF(v4u, VA, (r * DVV + (j - 128)) * 2u) = pk8(v0, v1); } };
struct FnResNew { const float* X; float* H; __device__ __forceinline__ void operator()(int row, int col, f32x4 v0, f32x4 v1) const {
        const unsigned o = ((unsigned)row * DM + col) * 4u; const f32x4 x0 = GOFF(const f32x4, X, o), x1 = GOFF(const f32x4, X, o + 16u);
        GOFF(f32x4, H, o) = x0 + v0; GOFF(f32x4, H, o + 16u) = x1 + v1; } };
__device__ __forceinline__ float swiglu1(float a, float b) { return a * b * __builtin_amdgcn_rcpf(1.f + __builtin_amdgcn_exp2f(-1.4426950408889634f * a)); }
struct FnSwiglu { bf16* ACT; __device__ __forceinline__ void operator()(int row, int col, f32x4 a0, f32x4 a1, f32x4 b0, f32x4 b1) const {
        f32x4 r0, r1;
#pragma unroll
        for (int i = 0; i < 4; ++i) { r0[i] = swiglu1(a0[i], b0[i]); r1[i] = swiglu1(a1[i], b1[i]); }
        GOFF(v4u, ACT, (((unsigned)(row >> 8) * (FF / 64) + (unsigned)(col >> 6)) * 16384u + (unsigned)((row & 255) * 64 + (col & 63))) * 2u) = pk8(r0, r1); } };
template <class Inner> struct EpiI8 {
    static constexpr bool PERM = true, AFTER_DRAIN = false; Inner E; const float* SA; const gu32* CMAX;
    __device__ __forceinline__ void operator()(const pg8::f32x4 (&acc_c)[2][2][4][2], const pg8::Unit& u, int wr, int wc, int fr, int fq) const {
        pg8::f32x4 (&acc)[2][2][4][2] = const_cast<pg8::f32x4 (&)[2][2][4][2]>(acc_c);
        const int row0 = u.pm * 256 + wr * 64 + fr, col0 = u.pn * 256 + wc * 32 + 8 * fq;
        f32x4 sw[2][2];
#pragma unroll
        for (int bj = 0; bj < 2; ++bj)
#pragma unroll
            for (int n = 0; n < 2; ++n) { const v4u b = *(const GAS v4u*)(CMAX + col0 + bj * 128 + 4 * n);
                sw[bj][n] = (f32x4){__uint_as_float(b.x), __uint_as_float(b.y), __uint_as_float(b.z), __uint_as_float(b.w)} * (1.f / 127.f); }
#pragma unroll
        for (int ai = 0; ai < 2; ++ai)
#pragma unroll
            for (int m = 0; m < 4; ++m) { const float sa = SA[row0 + ai * 128 + m * 16];
#pragma unroll
                for (int bj = 0; bj < 2; ++bj)
#pragma unroll
                    for (int n = 0; n < 2; ++n) { const pg8::i32x4_t iv = __builtin_bit_cast(pg8::i32x4_t, acc[ai][bj][m][n]);
                        acc[ai][bj][m][n] = (f32x4){(float)iv.x, (float)iv.y, (float)iv.z, (float)iv.w} * sw[bj][n] * sa; } }
        E(acc, u, wr, wc, fr, fq);
    }
};
struct EpiSB {
    static constexpr bool PERM = true, AFTER_DRAIN = false;
    bf16* KB; bf16* VB; bf16* QB; float* GATE; const f32x2* tab;
    __device__ __forceinline__ void operator()(const pg8::f32x4 (&acc)[2][2][4][2], const pg8::Unit& u, int wr, int wc, int fr, int fq) const {
        const int row0 = u.pm * 256 + wr * 64 + fr, cl = wc * 32 + 8 * fq;
        const int b = row0 >> 11, s0 = row0 & 2047;
        if (u.pn < 9) {
#pragma unroll
            for (int bj = 0; bj < 2; ++bj) { const int col = u.pn * 256 + bj * 128 + cl, kh = col / 192, dp = col - kh * 192, br = kh >> 2, g = kh & 3;
                const unsigned ob = ((unsigned)br * (unsigned)KB_BR + ((unsigned)((b * NG + g) * SEQ + s0)) * DQK + dp) * 2u, tb = ((unsigned)row0 * 96 + (dp >> 1)) * 8u;
#pragma unroll
                for (int ai = 0; ai < 2; ++ai) { f32x4 t0[4], t1[4];
#pragma unroll
                    for (int m = 0; m < 4; ++m) { const GAS char* tp = (const GAS char*)tab + tb + (unsigned)(ai * 128 + m * 16) * 768u; t0[m] = *(const GAS f32x4*)tp; t1[m] = *(const GAS f32x4*)(tp + 16); }
#pragma unroll
                    for (int m = 0; m < 4; ++m) { const unsigned ro = ai * 128 + m * 16; f32x4 v0 = acc[ai][bj][m][0], v1 = acc[ai][bj][m][1];
                        rope4r(v0, v1, t0[m], t1[m]); GOFF(v4u, KB, ob + ro * (DQK * 2u)) = pk8(v0, v1); }
                    SBAR(); } }
        } else if (u.pn < 15) {
#pragma unroll
            for (int bj = 0; bj < 2; ++bj) { const int c2 = (u.pn - 9) * 256 + bj * 128 + cl, kh = c2 >> 7, dv = c2 & 127, br = kh >> 2, g = kh & 3;
                const unsigned ob = ((unsigned)br * (unsigned)VB_BR + ((unsigned)((b * NG + g) * SEQ + s0)) * DVV + dv) * 2u;
#pragma unroll
                for (int ai = 0; ai < 2; ++ai)
#pragma unroll
                    for (int m = 0; m < 4; ++m) { const unsigned ro = ai * 128 + m * 16; GOFF(v4u, VB, ob + ro * (DVV * 2u)) = pk8(acc[ai][bj][m][0], acc[ai][bj][m][1]); } }
        } else if (u.pn < 39) {
#pragma unroll
            for (int bj = 0; bj < 2; ++bj) { const int c3 = (u.pn - 15) * 256 + bj * 128 + cl, h = c3 / 192, dp = c3 - h * 192;
                const unsigned ob = ((unsigned)row0 * UQ_N + c3) * 2u, tb = ((unsigned)row0 * 96 + (dp >> 1)) * 8u;
#pragma unroll
                for (int ai = 0; ai < 2; ++ai) { f32x4 t0[4], t1[4];
#pragma unroll
                    for (int m = 0; m < 4; ++m) { const GAS char* tp = (const GAS char*)tab + tb + (unsigned)(ai * 128 + m * 16) * 768u; t0[m] = *(const GAS f32x4*)tp; t1[m] = *(const GAS f32x4*)(tp + 16); }
#pragma unroll
                    for (int m = 0; m < 4; ++m) { const unsigned ro = ai * 128 + m * 16; f32x4 v0 = acc[ai][bj][m][0], v1 = acc[ai][bj][m][1];
                        rope4r(v0, v1, t0[m], t1[m]); GOFF(v4u, QB, ob + ro * (UQ_N * 2u)) = pk8(v0 * QSCALE, v1 * QSCALE); }
                    SBAR(); } }
        } else {
            if (cl < 96) {
                const unsigned ob = ((unsigned)row0 * 96 + cl) * 4u;
#pragma unroll
                for (int ai = 0; ai < 2; ++ai)
#pragma unroll
                    for (int m = 0; m < 4; ++m) { const unsigned ro = ai * 128 + m * 16; f32x4 g0, g1;
#pragma unroll
                        for (int i = 0; i < 4; ++i) { g0[i] = sigmoidf_(acc[ai][0][m][0][i]); g1[i] = sigmoidf_(acc[ai][0][m][1][i]); }
                        GOFF(f32x4, GATE, ob + ro * 384u) = g0; GOFF(f32x4, GATE, ob + ro * 384u + 16u) = g1; }
            }
        }
    }
};
__device__ __forceinline__ int v_st(int k, int c) { const int kk = (k & ~0xC) | ((k & 4) << 1) | ((k & 8) >> 1); return ((kk >> 3) * 4 + (c >> 5)) * 512 + ((kk & 7) * 32 + (c & 31)) * 2; }
__device__ __forceinline__ int v_rd_base(int lane) { return ((lane & 3) << 3) | (((lane >> 2) & 3) << 6) | (((lane >> 4) & 1) << 5) | (((lane >> 5) & 1) << 8); }
constexpr int v_rd_off(int d0, int ks, int half) { return d0 * 512 + ks * 4096 + half * 2048; }

__device__ __forceinline__ void qkt(f32x16& p0, f32x16& p1, LAS unsigned char* Kl, int r32, int hi, const bf16x8 (&qf)[12]) {
    p0 = (f32x16){}; p1 = (f32x16){};
    const int sw = (r32 >> 1) & 7;
    LAS unsigned char* kb[4];
#pragma unroll
    for (int k4 = 0; k4 < 4; ++k4) kb[k4] = Kl + r32 * 128 + (((2 * k4 + hi) ^ sw) << 4);
#pragma unroll
    for (int ks = 0; ks < 12; ++ks) { LAS unsigned char* a = kb[ks & 3] + (ks >> 2) * 8192;
        const bf16x8 b0 = *(const LAS bf16x8*)a, b1 = *(const LAS bf16x8*)(a + 4096);
        p0 = __builtin_amdgcn_mfma_f32_32x32x16_bf16(b0, qf[ks], p0, 0, 0, 0);
        p1 = __builtin_amdgcn_mfma_f32_32x32x16_bf16(b1, qf[ks], p1, 0, 0, 0); }
}
__device__ __forceinline__ void pv_tile(f32x16 (&o)[4], unsigned vb0, bf16x8 pa0, bf16x8 pa1, bf16x8 pa2, bf16x8 pa3) {
#define TRRD(dst, off) asm volatile("ds_read_b64_tr_b16 %0, %1 offset:%2" : "=&v"(dst) : "v"(vb0), "i"(off) : "memory")
#define PV_D0(d0) do { s16x4 l0, l1, l2, l3, h0, h1, h2, h3; constexpr int b_ = v_rd_off(d0, 0, 0); \
        TRRD(l0, b_); TRRD(h0, b_ + 2048); TRRD(l1, b_ + 4096); TRRD(h1, b_ + 6144); TRRD(l2, b_ + 8192); TRRD(h2, b_ + 10240); TRRD(l3, b_ + 12288); TRRD(h3, b_ + 14336); \
        asm volatile("s_waitcnt lgkmcnt(0)" ::: "memory"); SBAR(); \
        o[d0] = __builtin_amdgcn_mfma_f32_32x32x16_bf16((bf16x8){l0[0], l0[1], l0[2], l0[3], h0[0], h0[1], h0[2], h0[3]}, pa0, o[d0], 0, 0, 0); \
        o[d0] = __builtin_amdgcn_mfma_f32_32x32x16_bf16((bf16x8){l1[0], l1[1], l1[2], l1[3], h1[0], h1[1], h1[2], h1[3]}, pa1, o[d0], 0, 0, 0); \
        o[d0] = __builtin_amdgcn_mfma_f32_32x32x16_bf16((bf16x8){l2[0], l2[1], l2[2], l2[3], h2[0], h2[1], h2[2], h2[3]}, pa2, o[d0], 0, 0, 0); \
        o[d0] = __builtin_amdgcn_mfma_f32_32x32x16_bf16((bf16x8){l3[0], l3[1], l3[2], l3[3], h3[0], h3[1], h3[2], h3[3]}, pa3, o[d0], 0, 0, 0); } while (0)
    PV_D0(0); PV_D0(1); PV_D0(2); PV_D0(3);
#undef PV_D0
#undef TRRD
}
__device__ __forceinline__ void pack_p(const f32x16& p0, const f32x16& p1, bf16x8& pa0, bf16x8& pa1, bf16x8& pa2, bf16x8& pa3) {
#define PK4(P, B_, OUT) do { unsigned a0 = cvtpk(P[B_+0], P[B_+1]), a1 = cvtpk(P[B_+2], P[B_+3]); unsigned b0 = cvtpk(P[B_+4], P[B_+5]), b1 = cvtpk(P[B_+6], P[B_+7]); \
        auto r0 = __builtin_amdgcn_permlane32_swap(a0, b0, false, false); auto r1 = __builtin_amdgcn_permlane32_swap(a1, b1, false, false); \
        v4u w = {r0[0], r1[0], r0[1], r1[1]}; OUT = __builtin_bit_cast(bf16x8, w); } while (0)
    PK4(p0, 0, pa0); PK4(p0, 8, pa1); PK4(p1, 0, pa2); PK4(p1, 8, pa3);
#undef PK4
}
__device__ __forceinline__ void mask_tile(f32x16& p0, f32x16& p1, int kb0, int hi, int klo, int khi, bool lb) {
    const float NEG = -__builtin_inff();
    const int dl = klo - kb0 - 4 * hi; const int dh = lb ? khi - kb0 - 4 * hi : -1000000;
#pragma unroll
    for (int r = 0; r < 16; ++r) { const int c = (r & 3) + 8 * (r >> 2);
        if (c < dl || c > dh) p0[r] = NEG;
        if (c + 32 < dl || c + 32 > dh) p1[r] = NEG; }
}
constexpr float ATT_THR = 6.f;
struct KvSrc { unsigned k[3], v[2]; };
__device__ __forceinline__ KvSrc kv_src(int wid, int lane) {
    KvSrc S;
#pragma unroll
    for (int i = 0; i < 3; ++i) { const int blk = wid * 3 + i, s = blk >> 3, r = 8 * (blk & 7) + (lane >> 3), c = (lane & 7) ^ ((r >> 1) & 7); S.k[i] = (unsigned)(r * 384 + (8 * s + c) * 16); }
#pragma unroll
    for (int i = 0; i < 2; ++i) { const int st = 2 * (wid * 2 + i) + (lane >> 5), kk = 8 * (st >> 2) + ((lane & 31) >> 2), k = (kk & ~0xC) | ((kk & 4) << 1) | ((kk & 8) >> 1), c = 32 * (st & 3) + 8 * (lane & 3);
        S.v[i] = (unsigned)(k * 256 + c * 2); }
    return S;
}
__device__ __forceinline__ void kv_dma_k(const KvSrc& S, LAS unsigned char* L, int koff, const bf16* __restrict__ Kg, int wid) {
    const GAS char* kg = (const GAS char*)Kg;
#pragma unroll
    for (int i = 0; i < 3; ++i) __builtin_amdgcn_global_load_lds((const GAS unsigned*)(kg + S.k[i]), (LAS unsigned*)(L + koff + (wid * 3 + i) * 1024), 16, 0, 0);
}
__device__ __forceinline__ void kv_dma_v(const KvSrc& S, LAS unsigned char* L, int voff, const bf16* __restrict__ Vg, int wid) {
    const GAS char* vg = (const GAS char*)Vg;
#pragma unroll
    for (int i = 0; i < 2; ++i) __builtin_amdgcn_global_load_lds((const GAS unsigned*)(vg + S.v[i]), (LAS unsigned*)(L + voff + (wid * 2 + i) * 1024), 16, 0, 0);
}
__device__ __forceinline__ void kv_dma(const KvSrc& S, LAS unsigned char* L, int koff, int voff, const bf16* __restrict__ Kg, const bf16* __restrict__ Vg, int wid) { kv_dma_k(S, L, koff, Kg, wid); kv_dma_v(S, L, voff, Vg, wid); }
__device__ __forceinline__ int next_tile(int j0, int jhi, unsigned bits) {
    if (j0 >= 32) return 32;
    const unsigned m = bits & (0xffffffffu << j0);
    const int j = m ? __builtin_ctz(m) : 32;
    return j < jhi ? j : 32;
}
#ifdef PROBE_ATT
#define ATT_PB0() const unsigned long long pb0_ = __builtin_amdgcn_s_memrealtime()
#define ATT_PB1() do { if (PROBE_ATT == 1) pr_att_acc += __builtin_amdgcn_s_memrealtime() - pb0_; } while (0)
#else
#define ATT_PB0()
#define ATT_PB1()
#endif
__device__ __forceinline__ float tile_rowmax(const f32x16& p0, const f32x16& p1) {
    float pmax = p0[0];
#pragma unroll
    for (int r = 1; r < 16; ++r) pmax = fmaxf(pmax, p0[r]);
#pragma unroll
    for (int r = 0; r < 16; ++r) pmax = fmaxf(pmax, p1[r]);
    return half_max(pmax);
}
__device__ __forceinline__ void attn_run(LAS unsigned char* L, const bf16* __restrict__ Kg, const bf16* __restrict__ Vg, int jlo, int jhi, unsigned tilebits,
                                         int klo, int khi, unsigned lanebits, const bf16x8 (&qf)[12], f32x16 (&o)[4], float& m_reg, float& l_reg, int tid, int wid, int lane, unsigned long long& pr_att_acc) {
    const int r32 = lane & 31, hi = lane >> 5;
    LAS float* al_l = (LAS float*)(L + ATT_WS + wid * 256);
    const unsigned vb0 = (unsigned)(size_t)(L + ATT_V) + (unsigned)v_rd_base(lane);
    int j = next_tile(jlo, jhi, tilebits);
    if (j >= 32) return;
    int lane_o = lane; asm volatile("" : "+v"(lane_o));
    const KvSrc S = kv_src(wid, lane_o);
    int jn = next_tile(j + 1, jhi, tilebits);
    __syncthreads();
    kv_dma(S, L, ATT_K, ATT_V, Kg + (size_t)j * 64 * DQK, Vg + (size_t)j * 64 * DVV, wid);
    if (jn < 32) kv_dma_k(S, L, ATT_K + 24576, Kg + (size_t)jn * 64 * DQK, wid);
    __syncthreads();
    f32x16 pA0, pA1, pB0, pB1;
    qkt(pA0, pA1, L + ATT_K, r32, hi, qf);
    { const bool lb = (lanebits >> (j & 31)) & 1u; if (!__all(lb && j * 64 >= klo && j * 64 + 63 <= khi)) mask_tile(pA0, pA1, j * 64, hi, klo, khi, lb); }
    __syncthreads();
#define ATT_STEP(PX0, PX1, PY0, PY1, PAR) { \
        const int jnn = jn < 32 ? next_tile(jn + 1, jhi, tilebits) : 32; \
        if (jnn < 32) kv_dma_k(S, L, ATT_K + (PAR) * 24576, Kg + (size_t)jnn * 64 * DQK, wid); \
        if (jn < 32) kv_dma_v(S, L, ATT_V + ((PAR) ^ 1) * 16384, Vg + (size_t)jn * 64 * DVV, wid); \
        const float pmax = tile_rowmax(PX0, PX1); float alpha = 1.f; \
        if (!__all(pmax - m_reg <= ATT_THR)) { const float mn = fmaxf(m_reg, pmax); alpha = fast_exp2(m_reg - mn); m_reg = mn; \
            if (__any(alpha < 1.f)) { _Pragma("unroll") for (int d = 0; d < 4; ++d) o[d] *= alpha; } } \
        SBAR(); \
        qkt(PY0, PY1, L + ATT_K + ((PAR) ^ 1) * 24576, r32, hi, qf);        \
        float ps = 0.f; \
        _Pragma("unroll") for (int r = 0; r < 16; ++r) { PX0[r] = fast_exp2(PX0[r] - m_reg); ps += PX0[r]; } \
        _Pragma("unroll") for (int r = 0; r < 16; ++r) { PX1[r] = fast_exp2(PX1[r] - m_reg); ps += PX1[r]; } \
        _Pragma("unroll") for (int g_ = 0; g_ < 24; ++g_) { __builtin_amdgcn_sched_group_barrier(0x008, 1, 0); __builtin_amdgcn_sched_group_barrier(0x100, 1, 0); __builtin_amdgcn_sched_group_barrier(0x002, 4, 0); } \
        SBAR(); \
        ps = half_sum(ps); l_reg = l_reg * alpha + ps; \
        bf16x8 pa0, pa1, pa2, pa3; pack_p(PX0, PX1, pa0, pa1, pa2, pa3); \
        pv_tile(o, vb0 + (unsigned)(PAR) * 16384u, pa0, pa1, pa2, pa3); \
        if (jn < 32) { const bool lb = (lanebits >> (jn & 31)) & 1u; if (!__all(lb && jn * 64 >= klo && jn * 64 + 63 <= khi)) mask_tile(PY0, PY1, jn * 64, hi, klo, khi, lb); } \
        ATT_PB0(); __syncthreads(); ATT_PB1(); \
        if (jn >= 32) break; \
        j = jn; jn = jnn; }
#ifdef PROBE_ATT
    const unsigned long long pl0_ = __builtin_amdgcn_s_memrealtime();
#endif
    for (;;) { ATT_STEP(pA0, pA1, pB0, pB1, 0) ATT_STEP(pB0, pB1, pA0, pA1, 1) }
#ifdef PROBE_ATT
    if (PROBE_ATT == 2) pr_att_acc += __builtin_amdgcn_s_memrealtime() - pl0_;
#endif
#undef ATT_STEP
}
__device__ __forceinline__ void attn_tile(LAS unsigned char* L, int koff, unsigned vb, int kb0, bool lb, int klo, int khi, const bf16x8 (&qf)[12], f32x16 (&o)[4], float& m_reg, float& l_reg,
                                          LAS float* al_l, int r32, int hi) {
    f32x16 p0, p1;
    qkt(p0, p1, L + koff, r32, hi, qf);
    const bool lane_full = lb && kb0 >= klo && kb0 + 63 <= khi, lane_none = !lb || kb0 > khi || kb0 + 63 < klo;
    const bool cut = !(lane_full || lane_none);
    float m_off = 0.f;
    if (__any(cut)) mask_tile(p0, p1, kb0, hi, klo, khi, lb);
    else m_off = lane_none ? __builtin_inff() : 0.f;
    float pmax = p0[0];
#pragma unroll
    for (int r = 1; r < 16; ++r) pmax = fmaxf(pmax, p0[r]);
#pragma unroll
    for (int r = 0; r < 16; ++r) pmax = fmaxf(pmax, p1[r]);
    pmax = half_max(pmax) - m_off;
    float alpha = 1.f;
    if (!__all(pmax - m_reg <= ATT_THR)) { const float mn = fmaxf(m_reg, pmax); alpha = fast_exp2(m_reg - mn); m_reg = mn; }
    const float me = m_reg + m_off;
    float ps = 0.f;
#pragma unroll
    for (int r = 0; r < 16; ++r) { p0[r] = fast_exp2(p0[r] - me); ps += p0[r]; }
#pragma unroll
    for (int r = 0; r < 16; ++r) { p1[r] = fast_exp2(p1[r] - me); ps += p1[r]; }
    ps = half_sum(ps);
    l_reg = l_reg * alpha + ps;
    if (__any(alpha < 1.f)) {
#pragma unroll
        for (int d = 0; d < 4; ++d) o[d] *= alpha; }
    bf16x8 pa0, pa1, pa2, pa3;
    pack_p(p0, p1, pa0, pa1, pa2, pa3);
    pv_tile(o, vb, pa0, pa1, pa2, pa3);
}
__device__ __forceinline__ void attn_run1(LAS unsigned char* L, const bf16* __restrict__ Kg, const bf16* __restrict__ Vg, int jlo, int jhi, unsigned tilebits,
                                         int klo, int khi, unsigned lanebits, const bf16x8 (&qf)[12], f32x16 (&o)[4], float& m_reg, float& l_reg, int tid, int wid, int lane) {
    const int r32 = lane & 31, hi = lane >> 5;
    LAS float* al_l = (LAS float*)(L + ATT_WS + wid * 256);
    const unsigned vb0 = (unsigned)(size_t)(L + ATT_V) + (unsigned)v_rd_base(lane);
    int j = next_tile(jlo, jhi, tilebits);
    if (j >= 32) return;
    int lane_o = lane; asm volatile("" : "+v"(lane_o));
    const KvSrc S = kv_src(wid, lane_o);
    __syncthreads();
    kv_dma(S, L, ATT_K, ATT_V, Kg + (size_t)j * 64 * DQK, Vg + (size_t)j * 64 * DVV, wid);
    __syncthreads();
#define ATT_STEP(CUR) { \
        const int jn = next_tile(j + 1, jhi, tilebits); const bool more = jn < 32; \
        if (more) kv_dma(S, L, ATT_K + ((CUR) ^ 1) * 24576, ATT_V + ((CUR) ^ 1) * 16384, Kg + (size_t)jn * 64 * DQK, Vg + (size_t)jn * 64 * DVV, wid); \
        const int kb0 = j * 64; \
        const bool lb = (lanebits >> (j & 31)) & 1u; \
        const bool lane_any = lb && kb0 <= khi && kb0 + 63 >= klo; \
        if (__any(lane_any)) attn_tile(L, ATT_K + (CUR) * 24576, vb0 + (unsigned)(CUR) * 16384u, kb0, lb, klo, khi, qf, o, m_reg, l_reg, al_l, r32, hi); \
        __syncthreads(); \
        if (!more) break; \
        j = jn; }
    for (;;) { ATT_STEP(0) ATT_STEP(1) }
#undef ATT_STEP
}
__device__ __forceinline__ void store_rows_bf16(const f32x16 (&v)[4], void* base, unsigned rowoff_bytes, int hi) {
    GAS char* bp = (GAS char*)base; const unsigned ro = rowoff_bytes + (hi ? 16u : 0u);
#pragma unroll
    for (int d0 = 0; d0 < 4; ++d0)
#pragma unroll
        for (int q4 = 0; q4 < 4; q4 += 2) {
            const unsigned ax = cvtpk(v[d0][4 * q4 + 0], v[d0][4 * q4 + 1]), ay = cvtpk(v[d0][4 * q4 + 2], v[d0][4 * q4 + 3]);
            const unsigned bx = cvtpk(v[d0][4 * q4 + 4], v[d0][4 * q4 + 5]), by = cvtpk(v[d0][4 * q4 + 6], v[d0][4 * q4 + 7]);
            auto r0 = __builtin_amdgcn_permlane32_swap(ax, bx, false, false); auto r1 = __builtin_amdgcn_permlane32_swap(ay, by, false, false);
            const v4u w = {r0[0], r1[0], r0[1], r1[1]};
            *(GAS v4u*)(bp + ro + (unsigned)((32 * d0 + 8 * q4) * 2)) = w; }
}
__device__ __forceinline__ void load_q(bf16x8 (&qf)[12], const bf16* Qbase, unsigned eoff, int hi) {
    const GAS char* qb = (const GAS char*)Qbase; const unsigned bo = (eoff + 8u * hi) * 2u;
#pragma unroll
    for (int ks = 0; ks < 12; ++ks) qf[ks] = *(const GAS bf16x8*)(qb + bo + 32u * ks);
}

__device__ __forceinline__ void mla_attn_phase(Frame& F, const bf16* QA, const bf16* KA, const bf16* VA, bf16* OA, unsigned long long& pr_acc) {
    LAS unsigned char* L = F.lds + RING_OFF; const int tid = F.tid, wid = F.wave, lane = F.lane, r32 = lane & 31, hi = lane >> 5;
    for (int item = F.vcu; item < 512; item += F.G) {
        const int bh = item >> 2, x = item & 3, b = bh >> 5, h = bh & 31;
        for (int pass = 0; pass < 2; ++pass) {
            const int qb = pass ? 7 - x : x;
            const int t = qb * 256 + wid * 32 + r32; const unsigned tok = (unsigned)b * SEQ + t;
            bf16x8 qf[12]; load_q(qf, QA, tok * UQ_N + h * DQK, hi);
            f32x16 o[4] = {}; float m_reg = -1e30f, l_reg = 0.f;
            attn_run(L, KA + (size_t)bh * SEQ * DQK, VA + (size_t)bh * SEQ * DVV, 0, 4 * qb + 4, 0xffffffffu, 0, t, 0xffffffffu, qf, o, m_reg, l_reg, tid, wid, lane, pr_acc);
            const float w = 1.f / l_reg;
#pragma unroll
            for (int d0 = 0; d0 < 4; ++d0) o[d0] *= w;
            unsigned e0 = (tok * DM + (unsigned)(h * DVV)) * 2u;
            asm volatile("" : "+v"(e0));
            store_rows_bf16(o, OA, e0, hi);
        }
    }
}
__device__ __forceinline__ f32x16 wave_gemm_tile(const bf16* __restrict__ Arow, const bf16* __restrict__ Wrow, int K, int hi) {
    f32x16 acc = {};
    const bf16* a = Arow + 8 * hi; const bf16* w = Wrow + 8 * hi;
#pragma unroll 16
    for (int k = 0; k < K; k += 16) { const bf16x8 av = *(const GAS bf16x8*)(a + k), wv = *(const GAS bf16x8*)(w + k); acc = __builtin_amdgcn_mfma_f32_32x32x16_bf16(av, wv, acc, 0, 0, 0); }
    return acc;
}
__device__ __forceinline__ void rope_cols_phase(Frame& F, const bf16* XN, const bf16* WA, float* UA) {
    const int lane = F.lane, r32 = lane & 31, hi = lane >> 5, wid = F.wave, tid = F.tid;
    LAS float* P = (LAS float*)(F.lds + RING_OFF);
    for (int rb = F.vcu; rb < M / 32; rb += F.G) {
        const bf16* A = XN + (size_t)(32 * rb + r32) * DM + wid * 512;
        const bf16* W0 = WA + wt_off(2048 + r32, wid * 512, DM); const bf16* W1 = W0 + 32 * 64;
        f32x16 a0 = {}, a1 = {};
#pragma unroll 8
        for (int k = 0; k < 512; k += 16) { const int ko = (k >> 6) * 16384 + (k & 63) + 8 * hi;
            const bf16x8 av = *(const GAS bf16x8*)(A + k + 8 * hi), w0 = *(const GAS bf16x8*)(W0 + ko), w1 = *(const GAS bf16x8*)(W1 + ko);
            a0 = __builtin_amdgcn_mfma_f32_32x32x16_bf16(av, w0, a0, 0, 0, 0); a1 = __builtin_amdgcn_mfma_f32_32x32x16_bf16(av, w1, a1, 0, 0, 0); }
        __syncthreads();
#pragma unroll
        for (int r = 0; r < 16; ++r) { P[(wid * 32 + crow(r, hi)) * 64 + r32] = a0[r]; P[(wid * 32 + crow(r, hi)) * 64 + 32 + r32] = a1[r]; }
        __syncthreads();
        { const int e0 = tid * 4, row = e0 >> 6, col = e0 & 63; f32x4 s = {0.f, 0.f, 0.f, 0.f};
#pragma unroll
          for (int w = 0; w < 8; ++w) s += *(const LAS f32x4*)(P + (w * 32 + row) * 64 + col);
          *(GAS f32x4*)(UA + (size_t)(32 * rb + row) * A_IN_PAD + 2048 + col) = s; }
    }
}
__device__ __forceinline__ void compress1_phase(Frame& F, const bf16* KB0, const bf16* VB0, const bf16* W1K, const bf16* W1V, const float* biasK, const float* biasV, bf16* HIDK, bf16* HIDV) {
    const int lane = F.lane, r32 = lane & 31, hi = lane >> 5, wid = F.wave, tid = F.tid;
    LAS float* P = (LAS float*)(F.lds + RING_OFF);
    for (int id = F.vcu; id < 384 + 256; id += F.G) {
        const bool isK = id < 384; const int i2 = isK ? id : id - 384; const int nn = isK ? 6 : 4;
        const int grp = i2 / (4 * nn), mt = (i2 / nn) & 3, nt = i2 % nn;
        const int dw = isK ? 192 : 128, K = 32 * dw, Ks = K / 8;
        const bf16* A = (isK ? KB0 : VB0) + ((size_t)grp * SEQ + 16 * (32 * mt + r32)) * dw + wid * Ks;
        const bf16* W = (isK ? W1K : W1V) + (size_t)(32 * nt + r32) * K + wid * Ks;
        const f32x16 acc = wave_gemm_tile(A, W, Ks, hi);
        __syncthreads();
#pragma unroll
        for (int r = 0; r < 16; ++r) P[(wid * 32 + crow(r, hi)) * 32 + r32] = acc[r];
        __syncthreads();
        { const int e0 = tid * 2, row = e0 >> 5, col = e0 & 31;
          float s0 = 0.f, s1 = 0.f;
#pragma unroll
          for (int w = 0; w < 8; ++w) { s0 += P[(w * 32 + row) * 32 + col]; s1 += P[(w * 32 + row) * 32 + col + 1]; }
          const int n = 32 * nt + col; const float* bias = isK ? biasK : biasV;
          bf16* H = (isK ? HIDK : HIDV) + (size_t)(grp * 128 + 32 * mt + row) * dw + n;
          *(GAS unsigned*)H = cvtpk(gelu_tanh(s0 + bias[n]), gelu_tanh(s1 + bias[n + 1])); }
    }
}
__device__ __forceinline__ void compress2_phase(Frame& F, const bf16* HIDK, const bf16* HIDV, const bf16* W2K, const bf16* W2V, bf16* KC, bf16* VC) {
    const int gw = F.vcu * NWAVES + F.wave, NGW = F.G * NWAVES, lane = F.lane, r32 = lane & 31, hi = lane >> 5;
    for (int id = gw; id < 384 + 256; id += NGW) {
        const bool isK = id < 384; const int i2 = isK ? id : id - 384; const int nn = isK ? 6 : 4;
        const int mt = i2 / nn, nt = i2 % nn;
        const int dw = isK ? 192 : 128;
        const bf16* A = (isK ? HIDK : HIDV) + (size_t)(32 * mt + r32) * dw;
        const bf16* W = (isK ? W2K : W2V) + (size_t)(32 * nt + r32) * dw;
        const f32x16 acc = wave_gemm_tile(A, W, dw, hi);
        bf16* O = (isK ? KC : VC) + (size_t)(32 * mt) * dw + 32 * nt + r32;
#pragma unroll
        for (int r = 0; r < 16; ++r) { const int row = 32 * mt + crow(r, hi); O[(size_t)crow(r, hi) * dw] = (row & 127) == 127 ? (bf16)0 : (bf16)f2bf(acc[r]); }
    }
}

__device__ __forceinline__ unsigned bfpair_add(unsigned acc, float a, float b) {
    const float lo = __builtin_bit_cast(float, acc << 16) + a, hi = __builtin_bit_cast(float, acc & 0xffff0000u) + b; return cvtpk(lo, hi); }
__device__ __forceinline__ void nsa_phase(Frame& F, const bf16* QB, const bf16* KC, const bf16* VC, const bf16* KB, const bf16* VB, const float* GATE, bf16* OB, unsigned* ACCS, unsigned* QCTR, unsigned long long& pr_acc) {
    LAS unsigned char* L = F.lds + RING_OFF; const int wid = F.wave;
    LAS float* IMP = (LAS float*)(L + ATT_IMP);
    LAS float* SC = (LAS float*)(L + ATT_SC);
    LAS unsigned* SELW = (LAS unsigned*)(L + ATT_SELW);
    LAS unsigned* QW = (LAS unsigned*)(L + ATT_SELW + 128);
#ifdef PROBE_NSA
#define NSA_T(k) do { const unsigned long long now_ = __builtin_amdgcn_s_memrealtime(); if (PROBE_NSA == (k) || PROBE_NSA == 9) pr_acc += now_ - pr_last; pr_last = now_; } while (0)
    unsigned long long pr_last = __builtin_amdgcn_s_memrealtime();
#else
#define NSA_T(k) do { } while (0)
#endif
    const int q0 = (int)((xb_xcc_id() >> 1) & 3u);
    for (int qi = 0; qi < 4; ++qi) { const int g = (q0 + qi) & 3;
    unsigned nxt = 0u;
    if (fresh_tid(wid) == 0) nxt = __hip_atomic_fetch_add(QCTR + 64 * g, 1u, __ATOMIC_RELAXED, __HIP_MEMORY_SCOPE_AGENT);
    for (;;) {
        const int tid = fresh_tid(wid);
        const int lane = tid & 63, r32 = lane & 31, hi = lane >> 5;
        if (tid == 0) QW[0] = nxt;
        __syncthreads();
        const int qidx = (int)QW[0];
        if (qidx >= 256) { __syncthreads(); break; }
        if (tid == 0) nxt = __hip_atomic_fetch_add(QCTR + 64 * g, 1u, __ATOMIC_RELAXED, __HIP_MEMORY_SCOPE_AGENT);
        NSA_T(0);
        const unsigned vb0 = (unsigned)(size_t)(L + ATT_V) + (unsigned)v_rd_base(lane);
        const int b = qidx & 3, ch = 63 - (qidx >> 2), t0 = ch * 32, t = t0 + r32;
        const unsigned tok = (unsigned)b * SEQ + t; const int head = g * HPG + wid;
        const unsigned goff = (tok * 96 + head * 3) * 4u;
        unsigned accp[4][8];
        const float gate0 = GOFF(const float, GATE, goff), gate1 = GOFF(const float, GATE, goff + 4u), gate2 = GOFF(const float, GATE, goff + 8u);
        unsigned aoff = (((unsigned)blockIdx.x * 8 + wid) * 64 + lane) * 128u;
        asm volatile("" : "+v"(aoff));
        {
            const bf16* Kg = KC + (size_t)(b * NG + g) * 128 * DQK; const bf16* Vg = VC + (size_t)(b * NG + g) * 128 * DVV;
            f32x16 pA0, pA1, pB0, pB1;
            { bf16x8 qc[12]; load_q(qc, QB, tok * UQ_N + head * DQK, hi);
              __syncthreads();
              { const KvSrc S = kv_src(wid, lane); kv_dma(S, L, ATT_K, ATT_V, Kg, Vg, wid); kv_dma(S, L, ATT_K2, ATT_V + 16384, Kg + 64 * DQK, Vg + 64 * DVV, wid); }
              if (tid < 32) SELW[tid] = 0u;
              __syncthreads();
              qkt(pA0, pA1, L + ATT_K, r32, hi, qc);
              qkt(pB0, pB1, L + ATT_K2, r32, hi, qc); }
            const int khi = t >= 31 ? ((t - 31) >> 4) : -1;
            mask_tile(pA0, pA1, 0, hi, 0, khi, true);
            mask_tile(pB0, pB1, 64, hi, 0, khi, true);
            float mx = -__builtin_inff();
#pragma unroll
            for (int r = 0; r < 16; ++r) mx = fmaxf(fmaxf(mx, pA0[r]), fmaxf(pA1[r], fmaxf(pB0[r], pB1[r])));
            mx = half_max(mx);
            const float ms = (mx == -__builtin_inff()) ? 0.f : mx;
            float ps = 0.f;
#pragma unroll
            for (int r = 0; r < 16; ++r) { pA0[r] = fast_exp2(pA0[r] - ms); pA1[r] = fast_exp2(pA1[r] - ms); pB0[r] = fast_exp2(pB0[r] - ms); pB1[r] = fast_exp2(pB1[r] - ms); ps += (pA0[r] + pA1[r]) + (pB0[r] + pB1[r]); }
            ps = half_sum(ps);
            const float inv = ps > 0.f ? 1.f / ps : 0.f;
#pragma unroll
            for (int r = 0; r < 16; ++r) { pA0[r] *= inv; pA1[r] *= inv; pB0[r] *= inv; pB1[r] *= inv; }
            LAS float* imp = IMP + (wid * 32 + r32) * 32;
#define IMP_MAIN(P, base) do { _Pragma("unroll") for (int q4 = 0; q4 < 4; ++q4) imp[(base) + hi + 2 * q4] = (P[4 * q4] + P[4 * q4 + 1]) + (P[4 * q4 + 2] + P[4 * q4 + 3]); } while (0)
            IMP_MAIN(pA0, 0); IMP_MAIN(pA1, 8); IMP_MAIN(pB0, 16); IMP_MAIN(pB1, 24);
            asm volatile("s_waitcnt lgkmcnt(0)" ::: "memory");
#define IMP_EXTRA(P, base) do { _Pragma("unroll") for (int q4 = 0; q4 < 4; ++q4) { const int J1 = (base) + hi + 2 * q4 + 1; if (J1 < 32) imp[J1] += P[4 * q4 + 3]; } } while (0)
            IMP_EXTRA(pA0, 0); IMP_EXTRA(pA1, 8); IMP_EXTRA(pB0, 16); IMP_EXTRA(pB1, 24);
#undef IMP_MAIN
#undef IMP_EXTRA
            f32x16 o[4] = {}; bf16x8 pa0, pa1, pa2, pa3;
            pack_p(pA0, pA1, pa0, pa1, pa2, pa3); pv_tile(o, vb0, pa0, pa1, pa2, pa3);
            pack_p(pB0, pB1, pa0, pa1, pa2, pa3); pv_tile(o, vb0 + 16384u, pa0, pa1, pa2, pa3);
#pragma unroll
            for (int d0 = 0; d0 < 4; ++d0)
#pragma unroll
                for (int i = 0; i < 8; ++i) accp[d0][i] = cvtpk(o[d0][2 * i] * gate0, o[d0][2 * i + 1] * gate0);
        }
        NSA_T(1);
        __syncthreads();
        { const int tid2 = fresh_tid(wid); const int tk = tid2 >> 4, jj = tid2 & 15, tt = t0 + tk, cur = tt >> 6;
#pragma unroll
          for (int e = 0; e < 2; ++e) { const int j = jj + 16 * e; float s = 0.f;
#pragma unroll
              for (int w = 0; w < 8; ++w) s += IMP[(w * 32 + tk) * 32 + j];
              const bool valid = j <= cur, forced = valid && (j == 0 || j == cur || j == cur - 1);
              SC[tk * 32 + j] = valid ? s + (forced ? 1e4f : 0.f) : -__builtin_inff(); }
          __syncthreads();
          unsigned bits = 0u;
#pragma unroll
          for (int e = 0; e < 2; ++e) { const int j = jj + 16 * e; const float sj = SC[tk * 32 + j]; int rank = 0;
              for (int j2 = 0; j2 < 32; ++j2) { const float s2 = SC[tk * 32 + j2]; rank += (s2 > sj || (s2 == sj && j2 < j)) ? 1 : 0; }
              if (j <= cur && rank < 16) bits |= 1u << j; }
          if (bits) __hip_atomic_fetch_or(&SELW[tk], bits, __ATOMIC_RELAXED, __HIP_MEMORY_SCOPE_WORKGROUP);
          __syncthreads(); }
        NSA_T(2);
        const unsigned sel = SELW[r32];
        unsigned un = sel;
        un |= swz_xor_u<1>(un); un |= swz_xor_u<2>(un); un |= swz_xor_u<4>(un); un |= swz_xor_u<8>(un); un |= swz_xor_u<16>(un);
        un = __builtin_amdgcn_readfirstlane(un);
        const size_t slab = (size_t)(b * NG + g) * SEQ;
        const int jhi = ((t0 + 31) >> 6) + 1;
        const int wlo = t0 - 511 > 0 ? t0 - 511 : 0, wklo = t - 511 > 0 ? t - 511 : 0;
        for (int br = 1; br <= 2; ++br) {
            const bool isw = br == 2;
            unsigned qoff = tok * UQ_N + head * DQK; asm volatile("" : "+v"(qoff));
            bf16x8 qf[12]; load_q(qf, QB, qoff, hi);
            f32x16 o[4] = {}; float m_reg = -1e30f, l_reg = 0.f;
            attn_run1(L, KB + (size_t)br * KB_BR + slab * DQK, VB + (size_t)br * VB_BR + slab * DVV, isw ? (wlo >> 6) : 0, jhi, isw ? 0xffffffffu : un, isw ? wklo : 0, t, isw ? 0xffffffffu : sel, qf, o, m_reg, l_reg, tid, wid, lane);
            NSA_T(2 + br);
            const float wgt = (isw ? gate2 : gate1) / l_reg;
            if (!isw) {
#pragma unroll
                for (int d0 = 0; d0 < 4; ++d0)
#pragma unroll
                    for (int i = 0; i < 8; ++i) accp[d0][i] = bfpair_add(accp[d0][i], o[d0][2 * i] * wgt, o[d0][2 * i + 1] * wgt);
            } else {
#pragma unroll
                for (int d0 = 0; d0 < 4; ++d0)
#pragma unroll
                    for (int i = 0; i < 8; ++i) { o[d0][2 * i] = __builtin_bit_cast(float, accp[d0][i] << 16) + o[d0][2 * i] * wgt; o[d0][2 * i + 1] = __builtin_bit_cast(float, accp[d0][i] & 0xffff0000u) + o[d0][2 * i + 1] * wgt; }
                unsigned e0 = (tok * DM + (unsigned)(head * DVV)) * 2u;
                asm volatile("" : "+v"(e0));
                store_rows_bf16(o, OB, e0, hi);
            }
            NSA_T(5);
        }
    }
    }
}
constexpr int N_PHASES = 20;
struct Args { const float* in[24]; float* out; unsigned char* ws; int ph_lo, ph_hi; };
__global__ void __launch_bounds__(NWAVES * 64, 2) yoco_fwd(Args args) {
    extern __shared__ __attribute__((aligned(16))) unsigned char lds[];
    Frame F;
    F.lds = (LAS unsigned char*)lds;
    F.MISC = (volatile LAS unsigned*)(F.lds + MISC_OFF);
    F.tid = threadIdx.x; F.lane = F.tid & 63; F.wave = __builtin_amdgcn_readfirstlane(F.tid >> 6);
    F.G = gridDim.x; { const int bx = blockIdx.x; F.vcu = (F.G % 8 == 0) ? (bx % 8) * (F.G / 8) + bx / 8 : bx; }
    unsigned char* ws = args.ws; F.ws = ws;
    F.ctl = (gu32*)(ws + WS_CTL);
    for (int u = F.tid; u < (LDS_BYTES - LDSCTL_OFF) / 4; u += NWAVES * 64) ((LAS unsigned*)(F.lds + LDSCTL_OFF))[u] = 0u;
    __syncthreads();
    XcdBarrier bar = xcd_barrier_post((unsigned*)(F.ctl + CW_BAR), F.MISC + 8);
    frame_fresh(F);
    const int lo = args.ph_lo, hi = args.ph_hi;
    unsigned long long pr_nsa = 0;
#ifdef PROBE_TS
    unsigned long long pr_t0 = __builtin_amdgcn_s_memrealtime(), pr_t1 = 0, pr_c0 = 0, pr_c1 = 0;
#endif
#ifndef PH_MASK
#define PH_MASK 0xFFFFFu
#endif
#define IN(k) (((PH_MASK >> (k)) & 1u) && lo <= (k) && (k) < hi)
#ifndef REP_MASK
#define REP_MASK 0u
#endif
#define REP(k) for (int rep_ = 0; rep_ < ((((unsigned)REP_MASK >> (k)) & 1u) ? 2 : 1); ++rep_)
#define INR(k) (lo <= (k) && (k) < hi)
#ifdef PROBE_TS
#define SEAM(k) do { if ((k) == PROBE_TS - 1) { pr_c0 = __builtin_amdgcn_s_memtime(); pr_t0 = (PROBE_CLK ? __builtin_amdgcn_s_memrealtime() : pr_t0); } if (INR(k) && INR((k) + 1)) xcd_barrier(bar); if ((k) == PROBE_TS) { pr_t1 = __builtin_amdgcn_s_memrealtime(); pr_c1 = __builtin_amdgcn_s_memtime(); } } while (0)
#else
#define SEAM(k) do { if (INR(k) && INR((k) + 1)) xcd_barrier(bar); } while (0)
#endif

    LAS unsigned char* RING = F.lds + RING_OFF;
    const int bid = (int)blockIdx.x;

    REP(0) if (IN(0)) {
        frame_fresh(F);
        for (int l = 1; l >= 0; --l) {
            if (l == 0) {
                conv_colmax(F, args.in[19], DM, DM, nullptr, F.ctl + CW_CMAX + CM_WOB, 0, MapId{});
                conv_colmax(F, args.in[10], DM, 3840, args.in[9], F.ctl + CW_CMAX, 0, InvSkv{});
                conv_colmax(F, args.in[18], DM, 6240, args.in[17], F.ctl + CW_CMAX, 3840, InvBin{});
            }
            conv_fast(F, args.in[22] + (size_t)l * FF * DM, FF, DM, nullptr, (bf16*)(ws + WS_WFO + l * WFO_STRIDE), 0, MapId{});
            if (l == FFN_Q8_LAYER) conv_colmax(F, args.in[21] + (size_t)l * DM * 2 * FF, DM, 2 * FF, args.in[20] + (size_t)l * DM, F.ctl + CW_CMAX + SB_N, 0, InvFfi{});
            else conv_fast(F, args.in[21] + (size_t)l * DM * 2 * FF, DM, 2 * FF, args.in[20] + (size_t)l * DM, (bf16*)(ws + WS_WFI + l * WFI_STRIDE), 0, InvFfi{});
        }
        conv_colmax(F, args.in[8], DM, DM, nullptr, F.ctl + CW_CMAX + CM_WOA, 0, MapId{});
        conv_colmax(F, args.in[7], KVL, UKV_N, args.in[6], F.ctl + CW_CMAX + CM_WUKV, 0, MapId{});
        conv_colmax(F, args.in[5], QL, UQ_N, args.in[4], F.ctl + CW_CMAX + CM_WUQ, 0, InvUq{});
        conv_fast(F, args.in[3], DM, A_IN, args.in[2], (bf16*)(ws + WS_WA), 0, MapId{});
        zero_rows(F, (bf16*)(ws + WS_WA), DM, A_IN, A_IN_PAD);
        conv_matrix(F, args.in[12], 192, nullptr, (bf16*)(ws + WS_W1K), 6144, 192, 0, MapId{}, MapW1kRow{});
        conv_matrix(F, args.in[13], 192, nullptr, (bf16*)(ws + WS_W2K), 192, 192, 0, MapW2kCol{}, MapId{});
        conv_matrix(F, args.in[15], 128, nullptr, (bf16*)(ws + WS_W1V), 4096, 128, 0, MapId{}, MapId{});
        conv_matrix(F, args.in[16], 128, nullptr, (bf16*)(ws + WS_W2V), 128, 128, 0, MapId{}, MapId{});
        rope_tables(F, (const int*)args.in[1], (f32x2*)(ws + WS_TABA), (f32x2*)(ws + WS_TABB));
        pe_bias(F, args.in[11], args.in[12], 6144, 192, (float*)(ws + WS_BIAS));
        pe_bias(F, args.in[14], args.in[15], 4096, 128, (float*)(ws + WS_BIAS) + 256);
        norm_phase(F, args.in[0], (bf16*)(ws + WS_XN));
    }
    SEAM(0);
    REP(1) if (IN(1)) { pg8::Gemm g{(const bf16*)(ws + WS_XN), (const bf16*)(ws + WS_WA), M, 2048, DM}; pg8::StaticOrder S; S.init(M, 2048, F.G, bid);
        EpiRow8<FnUA> E{FnUA{(float*)(ws + WS_UA)}}; pg8::gemm_phase<EpiRow8<FnUA>, pg8::StaticOrder, true, true, false, true>(RING, g, S, E, F.wave);
        frame_fresh(F); rope_cols_phase(F, (const bf16*)(ws + WS_XN), (const bf16*)(ws + WS_WA), (float*)(ws + WS_UA)); }
    SEAM(1);
    REP(2) if (IN(2)) { frame_fresh(F); conv_fast_q8(F, args.in[8], DM, DM, nullptr, (signed char*)(ws + WS_WOA), F.ctl + CW_CMAX + CM_WOA, 0, MapId{});
        conv_fast_q8(F, args.in[5], QL, UQ_N, args.in[4], (signed char*)(ws + WS_WUQ), F.ctl + CW_CMAX + CM_WUQ, 0, InvUq{});
        conv_fast_q8(F, args.in[7], KVL, UKV_N, args.in[6], (signed char*)(ws + WS_WUKV), F.ctl + CW_CMAX + CM_WUKV, 0, MapId{});
        mla_latent_phase(F, (const float*)(ws + WS_UA), (signed char*)(ws + WS_CQ), (signed char*)(ws + WS_CKV), (float*)(ws + WS_SA) + 8192, (float*)(ws + WS_SA) + 16384, (bf16*)(ws + WS_KA), (const f32x2*)(ws + WS_TABA)); }
    SEAM(2);
    REP(3) if (IN(3)) {
        { pg8::Gemm g{(const bf16*)(ws + WS_CQ), (const bf16*)(ws + WS_WUQ), M, UQ_N, QL / 2}; pg8::StaticOrder S; S.init(M, UQ_N, F.G, bid);
          EpiI8<EpiRow8<FnQa>> E{EpiRow8<FnQa>{FnQa{(bf16*)(ws + WS_QA), (const f32x2*)(ws + WS_TABA)}}, (const float*)(ws + WS_SA) + 8192, F.ctl + CW_CMAX + CM_WUQ};
          pg8::gemm_phase<EpiI8<EpiRow8<FnQa>>, pg8::StaticOrder, true, true, false, true, true>(RING, g, S, E, F.wave); }
        __syncthreads();
        { pg8::Gemm g{(const bf16*)(ws + WS_CKV), (const bf16*)(ws + WS_WUKV), M, UKV_N, KVL / 2}; pg8::StaticOrder S; S.init(M, UKV_N, F.G, bid);
          EpiI8<EpiRow8<FnKVa>> E{EpiRow8<FnKVa>{FnKVa{(bf16*)(ws + WS_KA), (bf16*)(ws + WS_VA)}}, (const float*)(ws + WS_SA) + 16384, F.ctl + CW_CMAX + CM_WUKV};
          pg8::gemm_phase<EpiI8<EpiRow8<FnKVa>>, pg8::StaticOrder, true, true, false, true, true>(RING, g, S, E, F.wave); }
    }
    SEAM(3);
    REP(4) if (IN(4)) { frame_fresh(F); mla_attn_phase(F, (const bf16*)(ws + WS_QA), (const bf16*)(ws + WS_KA), (const bf16*)(ws + WS_VA), (bf16*)(ws + WS_OA), pr_nsa); }
    SEAM(4);
    if (IN(5)) { frame_fresh(F); quant_rows_phase(F, (const bf16*)(ws + WS_OA), (signed char*)(ws + WS_XN8), (float*)(ws + WS_SA)); xcd_barrier(bar); }
    REP(5) if (IN(5)) { pg8::Gemm g{(const bf16*)(ws + WS_XN8), (const bf16*)(ws + WS_WOA), M, DM, DM / 2}; pg8::StaticOrder S; S.init(M, DM, F.G, bid);
        EpiI8<EpiRow8<FnResNew>> E{EpiRow8<FnResNew>{FnResNew{args.in[0], (float*)(ws + WS_H)}}, (const float*)(ws + WS_SA), F.ctl + CW_CMAX + CM_WOA};
        pg8::gemm_phase<EpiI8<EpiRow8<FnResNew>>, pg8::StaticOrder, true, true, false, true, true>(RING, g, S, E, F.wave); }
    SEAM(5);
#define FFN_PHASES(layer, pb, HIN, HOUT) do { \
        REP((pb) + 6) if (IN((pb) + 6)) { frame_fresh(F); \
            if ((layer) == FFN_Q8_LAYER) { norm_phase_q8(F, (const float*)(ws + HIN), (signed char*)(ws + WS_XN8), (float*)(ws + WS_SA)); \
                conv_fast_q8(F, args.in[21] + (size_t)(layer) * DM * 2 * FF, DM, 2 * FF, args.in[20] + (size_t)(layer) * DM, (signed char*)(ws + WS_WFI + (layer) * WFI_STRIDE), F.ctl + CW_CMAX + SB_N, 0, InvFfi{}); } \
            else norm_phase(F, (const float*)(ws + HIN), (bf16*)(ws + WS_XN)); } \
        SEAM((pb) + 6); \
        REP((pb) + 7) if (IN((pb) + 7)) { \
            if ((layer) == FFN_Q8_LAYER) { pg8::Gemm g{(const bf16*)(ws + WS_XN8), (const bf16*)(ws + WS_WFI + (layer) * WFI_STRIDE), M, 2 * FF, DM / 2}; pg8::StaticOrder S; S.init(M, 2 * FF, F.G, bid); \
                EpiI8<EpiGate<FnSwiglu>> E{EpiGate<FnSwiglu>{FnSwiglu{(bf16*)(ws + WS_ACT)}}, (const float*)(ws + WS_SA), F.ctl + CW_CMAX + SB_N}; \
                pg8::gemm_phase<EpiI8<EpiGate<FnSwiglu>>, pg8::StaticOrder, true, true, false, true, true>(RING, g, S, E, F.wave); } \
            else { pg8::Gemm g{(const bf16*)(ws + WS_XN), (const bf16*)(ws + WS_WFI + (layer) * WFI_STRIDE), M, 2 * FF, DM}; pg8::StaticOrder S; S.init(M, 2 * FF, F.G, bid); \
                EpiGate<FnSwiglu> E{FnSwiglu{(bf16*)(ws + WS_ACT)}}; pg8::gemm_phase<EpiGate<FnSwiglu>, pg8::StaticOrder, true, true, false, true>(RING, g, S, E, F.wave); } } \
        SEAM((pb) + 7); \
        REP((pb) + 8) if (IN((pb) + 8)) { pg8::Gemm g{(const bf16*)(ws + WS_ACT), (const bf16*)(ws + WS_WFO + (layer) * WFO_STRIDE), M, DM, FF}; pg8::StaticOrder S; S.init(M, DM, F.G, bid); \
            EpiRow8<FnResNew> E{FnResNew{(const float*)(ws + HIN), (float*)(ws + HOUT)}}; pg8::gemm_phase<EpiRow8<FnResNew>, pg8::StaticOrder, true, true, true, true>(RING, g, S, E, F.wave); } \
        SEAM((pb) + 8); } while (0)
    FFN_PHASES(0, 0, WS_H, WS_H2);
    REP(9) if (IN(9)) { frame_fresh(F); norm_phase_q8(F, (const float*)(ws + WS_H2), (signed char*)(ws + WS_XN8), (float*)(ws + WS_SA));
        conv_fast_q8(F, args.in[10], DM, 3840, args.in[9], (signed char*)(ws + WS_WSB), F.ctl + CW_CMAX, 0, InvSkv{});
        conv_fast_q8(F, args.in[18], DM, 6240, args.in[17], (signed char*)(ws + WS_WSB), F.ctl + CW_CMAX, 3840, InvBin{});
        zero_rows8(F, (signed char*)(ws + WS_WSB), DM, 3840 + 6240, SB_N);
        conv_fast_q8(F, args.in[19], DM, DM, nullptr, (signed char*)(ws + WS_WOB), F.ctl + CW_CMAX + CM_WOB, 0, MapId{}); }
    SEAM(9);
    REP(10) if (IN(10)) { pg8::Gemm g{(const bf16*)(ws + WS_XN8), (const bf16*)(ws + WS_WSB), M, SB_N, DM / 2}; pg8::StaticOrder S; S.init(M, SB_N, F.G, bid);
        EpiI8<EpiSB> E{EpiSB{(bf16*)(ws + WS_KB), (bf16*)(ws + WS_VB), (bf16*)(ws + WS_QA), (float*)(ws + WS_GATE), (const f32x2*)(ws + WS_TABB)}, (const float*)(ws + WS_SA), F.ctl + CW_CMAX};
        pg8::gemm_phase<EpiI8<EpiSB>, pg8::StaticOrder, true, true, false, true, true>(RING, g, S, E, F.wave); }
    SEAM(10);
    REP(11) if (IN(11)) { frame_fresh(F); compress1_phase(F, (const bf16*)(ws + WS_KB), (const bf16*)(ws + WS_VB), (const bf16*)(ws + WS_W1K), (const bf16*)(ws + WS_W1V), (const float*)(ws + WS_BIAS), (const float*)(ws + WS_BIAS) + 256, (bf16*)(ws + WS_HIDK), (bf16*)(ws + WS_HIDV)); }
    SEAM(11);
    REP(12) if (IN(12)) { frame_fresh(F); compress2_phase(F, (const bf16*)(ws + WS_HIDK), (const bf16*)(ws + WS_HIDV), (const bf16*)(ws + WS_W2K), (const bf16*)(ws + WS_W2V), (bf16*)(ws + WS_KC), (bf16*)(ws + WS_VC)); }
    SEAM(12);
    REP(13) if (IN(13)) { frame_fresh(F); nsa_phase(F, (const bf16*)(ws + WS_QA), (const bf16*)(ws + WS_KC), (const bf16*)(ws + WS_VC), (const bf16*)(ws + WS_KB), (const bf16*)(ws + WS_VB), (const float*)(ws + WS_GATE), (bf16*)(ws + WS_OA), (unsigned*)(ws + WS_OC), (unsigned*)(F.ctl + CW_NSAQ), pr_nsa); }
    SEAM(13);
    if (IN(14)) { frame_fresh(F); quant_rows_phase(F, (const bf16*)(ws + WS_OA), (signed char*)(ws + WS_XN8), (float*)(ws + WS_SA)); }
    SEAM(14);
    REP(15) if (IN(15)) { pg8::Gemm g{(const bf16*)(ws + WS_XN8), (const bf16*)(ws + WS_WOB), M, DM, DM / 2}; pg8::StaticOrder S; S.init(M, DM, F.G, bid);
        EpiI8<EpiRow8<FnResNew>> E{EpiRow8<FnResNew>{FnResNew{(const float*)(ws + WS_H2), (float*)(ws + WS_H)}}, (const float*)(ws + WS_SA), F.ctl + CW_CMAX + CM_WOB};
        pg8::gemm_phase<EpiI8<EpiRow8<FnResNew>>, pg8::StaticOrder, true, true, false, true, true>(RING, g, S, E, F.wave); }
    SEAM(15);
    FFN_PHASES(1, 10, WS_H, WS_H2);
    REP(19) if (IN(19)) { frame_fresh(F); final_norm_phase(F, (const float*)(ws + WS_H2), args.in[23], args.out); }
#undef FFN_PHASES
#if defined(PROBE_NSA) || defined(PROBE_ATT)
    if (blockIdx.x == PROBE_BLK) { const unsigned long long wait = 4ull * pr_nsa; const unsigned long long s0 = __builtin_amdgcn_s_memrealtime(); while (__builtin_amdgcn_s_memrealtime() - s0 < wait) __builtin_amdgcn_s_sleep(8); }
#endif
#ifdef PROBE_TS
    if (blockIdx.x == 0) { unsigned long long wait = PROBE_CLK ? (pr_c1 - pr_c0) * 100ull / ((pr_t1 - pr_t0) + 1ull) * 100ull : 4ull * (pr_t1 - pr_t0);
        const unsigned long long s0 = __builtin_amdgcn_s_memrealtime(); while (__builtin_amdgcn_s_memrealtime() - s0 < wait) __builtin_amdgcn_s_sleep(8); }
#endif
#undef IN
#undef INR
#undef SEAM
}

extern "C" void kernel_launch(void* const* d_in, const int* in_sizes, int n_in, void* d_out, int out_size, void* d_ws, size_t ws_size, hipStream_t stream) {
    static int grid = 0;
    if (grid == 0) {
        if (n_in != 24 || out_size != M * DM || ws_size < WS_END) { fprintf(stderr, "kernel_launch: unexpected shapes (n_in %d out %d ws %zu need %zu)\n", n_in, out_size, ws_size, (size_t)WS_END); grid = -1; return; }
        int dev = 0, cus = 0, per_cu = 0;
        if (hipGetDevice(&dev) != hipSuccess || hipDeviceGetAttribute(&cus, hipDeviceAttributeMultiprocessorCount, dev) != hipSuccess) { grid = -1; return; }
        if (hipFuncSetAttribute((const void*)yoco_fwd, hipFuncAttributeMaxDynamicSharedMemorySize, LDS_BYTES) != hipSuccess) { fprintf(stderr, "kernel_launch: hipFuncSetAttribute failed\n"); grid = -1; return; }
        if (hipOccupancyMaxActiveBlocksPerMultiprocessor(&per_cu, (const void*)yoco_fwd, NWAVES * 64, LDS_BYTES) != hipSuccess || per_cu < 1)
            fprintf(stderr, "kernel_launch: occupancy query reports %d workgroups per CU\n", per_cu);
        (void)hipGetLastError();
        grid = cus;
    }
    if (grid < 0) return;
    if (hipMemsetAsync((char*)d_ws + WS_CTL, 0, CTL_ZERO_BYTES, stream) != hipSuccess) return;
    Args a{};
    for (int i = 0; i < 24; ++i) a.in[i] = (const float*)d_in[i];
    a.out = (float*)d_out; a.ws = (unsigned char*)d_ws;
#if MK_ONE_LAUNCH
    a.ph_lo = 0; a.ph_hi = N_PHASES;
    hipLaunchKernelGGL(yoco_fwd, dim3(grid), dim3(NWAVES * 64), LDS_BYTES, stream, a);
#else
    for (int p = 0; p < N_PHASES; ++p) { a.ph_lo = p; a.ph_hi = p + 1; hipLaunchKernelGGL(yoco_fwd, dim3(grid), dim3(NWAVES * 64), LDS_BYTES, stream, a); }
#endif
}
```

```cpp
#include <hip/hip_runtime.h>
#include <cstdio>
#include <cstdint>
#include <cmath>
#define MK_ONE_LAUNCH 1
#define FFN_Q8_BOTH 1
namespace pg8 {
#define PG8_LAS __attribute__((address_space(3)))
typedef unsigned short bf16_t;
typedef short bf16x8 __attribute__((ext_vector_type(8)));
typedef float f32x4 __attribute__((ext_vector_type(4)));
typedef unsigned u32x4 __attribute__((ext_vector_type(4)));
typedef int i32x4_t __attribute__((ext_vector_type(4)));
constexpr int BM = 256, BK = 64, HALF = 128, HTB = HALF * BK * 2  , STAGE_BYTES = 8 * HTB, NXCD = 8, WGM = 8;

__host__ __device__ __forceinline__ int lds_byte(int r, int c) { const int st = (r >> 4) * 2 + (c >> 5), rr = r & 15, cc = c & 31, ob = rr * 64 + cc * 2; return st * 1024 + (ob ^ (((ob >> 9) & 1) << 5)); }
__host__ __device__ __forceinline__ void stage_rc(int b, int& R, int& C) { const int st = b / 1024, sb = b % 1024, swz = sb ^ (((sb >> 9) & 1) << 5); R = (st >> 1) * 16 + swz / 64; C = (st & 1) * 32 + (swz % 64) / 2; }
__host__ __device__ __forceinline__ int perm32(int rho) { const int n = rho >> 4, i = rho & 15; return 8 * (i >> 2) + 4 * n + (i & 3); }

struct Unit { int pm, pn; };
struct Gemm { const bf16_t* A; const bf16_t* Bt; int M, N, K; };

struct StaticOrder {
    int nM, nN, nwg, G, c;
    __host__ __device__ void init(int M, int N, int G_, int c_) { nM = M / BM; nN = N / BM; nwg = nM * nN; G = G_; c = c_; }
    __host__ __device__ bool next(int i, Unit& u) const {
        const long L = (long)i * G + c; if (L >= nwg) return false;
        int wgid = (int)L; { const int q = nwg / NXCD, r = nwg % NXCD, xcd = wgid % NXCD, off = wgid / NXCD; wgid = (xcd < r ? xcd * (q + 1) : r * (q + 1) + (xcd - r) * q) + off; }
        const int nig = WGM * nN, gid = wgid / nig, fm = gid * WGM, gsz = (nM - fm) < WGM ? (nM - fm) : WGM;
        u.pm = fm + ((wgid % nig) % gsz); u.pn = (wgid % nig) / gsz; return true;
    }
    __device__ __forceinline__ void a_ready(const Unit&) const {}
    __device__ __forceinline__ void done(const Unit&) const {}
};

__device__ __forceinline__ unsigned cvt_pk_bf16(float lo, float hi) { unsigned r; asm volatile("v_cvt_pk_bf16_f32 %0, %1, %2" : "=v"(r) : "v"(lo), "v"(hi)); return r; }
template <class Epi, class Sched, bool ALIGN_EPI = false, bool SP2 = false, bool AT = false, bool BT = false, bool I8 = false>
__device__ __forceinline__ void gemm_phase(PG8_LAS unsigned char* lds, const Gemm g, const Sched& S, const Epi& E, const int wave_id  ) {
    unsigned zz_; asm volatile("v_mov_b32 %0, 0" : "=v"(zz_)); const int lane = (int)__builtin_amdgcn_mbcnt_hi(~0u, __builtin_amdgcn_mbcnt_lo(~0u, zz_));
    const int wid = wave_id, tid = wid * 64 + lane, wr = wid >> 2, wc = wid & 3, fr = lane & 15, fq = lane >> 4;
    const int K = g.K, nt = K / BK;
    unsigned voffA[2], voffB[2];
#pragma unroll
    for (int i = 0; i < 2; ++i) { int R, C; stage_rc(tid * 16 + i * 8192, R, C); const int Rb = Epi::PERM ? ((R & ~31) + perm32(R & 31)) : R;
        voffA[i] = (unsigned)(R * (AT ? BK : K) + C) * 2u; voffB[i] = (unsigned)(Rb * (BT ? BK : K) + C) * 2u; }
    const size_t kstepA = AT ? (size_t)(BM * BK * 2) : (size_t)(BK * 2), kstepB = BT ? (size_t)(BM * BK * 2) : (size_t)(BK * 2);
    const size_t hstepA = AT ? (size_t)(HALF * BK * 2) : (size_t)HALF * K * 2, hstepB = BT ? (size_t)(HALF * BK * 2) : (size_t)HALF * K * 2;
    const size_t tstep = (size_t)BM * K * 2;
    const unsigned ldsw = (unsigned)wid * 1024u;
    const int aoff = lds_byte(wr * 64 + fr, fq * 8), boff = lds_byte(wc * 32 + fr, fq * 8);
#define PG8_SA(b, h) (((b) * 2 + (h)) * HTB)
#define PG8_SB(b, h) ((4 + (b) * 2 + (h)) * HTB)
#define PG8_STAGE(bufoff, gbase, voff) do { _Pragma("unroll") for (int _i = 0; _i < 2; ++_i) \
        __builtin_amdgcn_global_load_lds((const unsigned*)((const char*)(gbase) + (voff)[_i]), (PG8_LAS unsigned*)(lds + (bufoff) + ldsw + _i * 8192), 16, 0, 0); } while (0)
#define PG8_LDA(dst, b, h) do { _Pragma("unroll") for (int m = 0; m < 4; ++m) _Pragma("unroll") for (int k = 0; k < 2; ++k) dst[m][k] = *(const PG8_LAS bf16x8*)(lds + PG8_SA(b, h) + aoff + m * 2048 + k * 1024); } while (0)
#define PG8_LDB(dst, b, h) do { _Pragma("unroll") for (int n = 0; n < 2; ++n) _Pragma("unroll") for (int k = 0; k < 2; ++k) dst[n][k] = *(const PG8_LAS bf16x8*)(lds + PG8_SB(b, h) + boff + n * 2048 + k * 1024); } while (0)
#define PG8_MMA(ai, bj, At, Bt) do { __builtin_amdgcn_s_setprio(1); _Pragma("unroll") for (int m = 0; m < 4; ++m) _Pragma("unroll") for (int n = 0; n < 2; ++n) _Pragma("unroll") for (int k = 0; k < 2; ++k) { \
        if constexpr (I8) acc[ai][bj][m][n] = __builtin_bit_cast(f32x4, __builtin_amdgcn_mfma_i32_16x16x64_i8(__builtin_bit_cast(i32x4_t, Bt[n][k]), __builtin_bit_cast(i32x4_t, At[m][k]), __builtin_bit_cast(i32x4_t, acc[ai][bj][m][n]), 0, 0, 0)); \
        else acc[ai][bj][m][n] = __builtin_amdgcn_mfma_f32_16x16x32_bf16(Bt[n][k], At[m][k], acc[ai][bj][m][n], 0, 0, 0); } __builtin_amdgcn_s_setprio(0); } while (0)
#define PG8_WAIT_V(n) asm volatile("s_waitcnt vmcnt(" #n ")" ::: "memory")
#define PG8_WAIT_L(n) asm volatile("s_waitcnt lgkmcnt(" #n ")" ::: "memory")
#define PG8_BAR __builtin_amdgcn_s_barrier()
#define PG8_SCHED __builtin_amdgcn_sched_barrier(0)
    Unit cur, nxt; int ui = 0;
    if (!S.next(0, cur)) return;
    f32x4 acc[2][2][4][2];
#pragma unroll
    for (int a = 0; a < 2; ++a)
#pragma unroll
        for (int b = 0; b < 2; ++b)
#pragma unroll
            for (int m = 0; m < 4; ++m)
#pragma unroll
                for (int n = 0; n < 2; ++n) acc[a][b][m][n] = (f32x4){0.f, 0.f, 0.f, 0.f};
    bf16x8 At[4][2], B0[2][2], B1[2][2];
    const char* cA = (const char*)g.A + (size_t)cur.pm * tstep; const char* cB = (const char*)g.Bt + (size_t)cur.pn * tstep;
    S.a_ready(cur);
    if constexpr (SP2) {
        PG8_STAGE(PG8_SB(0, 0), cB, voffB); PG8_STAGE(PG8_SB(0, 1), cB + hstepB, voffB); PG8_STAGE(PG8_SA(0, 0), cA, voffA); PG8_STAGE(PG8_SA(0, 1), cA + hstepA, voffA);
        if (wr == 1) PG8_BAR;
        PG8_WAIT_V(2); PG8_BAR;
        PG8_STAGE(PG8_SB(1, 0), cB + kstepB, voffB); PG8_STAGE(PG8_SA(1, 0), cA + kstepA, voffA); PG8_STAGE(PG8_SB(1, 1), cB + hstepB + kstepB, voffB);
        PG8_WAIT_V(6); PG8_BAR;
    } else {
        PG8_STAGE(PG8_SB(0, 0), cB, voffB); PG8_STAGE(PG8_SA(0, 0), cA, voffA); PG8_STAGE(PG8_SB(0, 1), cB + hstepB, voffB); PG8_STAGE(PG8_SA(0, 1), cA + hstepA, voffA);
        if (wr == 1) PG8_BAR;
        PG8_WAIT_V(4); PG8_BAR;
        PG8_STAGE(PG8_SB(1, 0), cB + kstepB, voffB); PG8_STAGE(PG8_SA(1, 0), cA + kstepA, voffA); PG8_STAGE(PG8_SB(1, 1), cB + hstepB + kstepB, voffB);
        PG8_WAIT_V(6); PG8_BAR;
    }
    for (;;) {
        const bool has_next = S.next(ui + 1, nxt);
        const char* nA = has_next ? (const char*)g.A + (size_t)nxt.pm * tstep : cA; const char* nB = has_next ? (const char*)g.Bt + (size_t)nxt.pn * tstep : cB;
        for (int t = 0; t < nt; t += 2) {
            const bool last = (t == nt - 2);
            const char* a1 = cA + (size_t)(t + 1) * kstepA;
            const char* a2 = last ? nA : cA + (size_t)(t + 2) * kstepA; const char* b2 = last ? nB : cB + (size_t)(t + 2) * kstepB;
            const char* a3 = a2 + kstepA; const char* b3 = b2 + kstepB;
            if (last && has_next) S.a_ready(nxt);
            if constexpr (SP2) {
            PG8_LDB(B0, 0, 0); PG8_LDB(B1, 0, 1); PG8_SCHED; PG8_LDA(At, 0, 0); PG8_STAGE(PG8_SA(1, 1), a1 + hstepA, voffA);
            PG8_WAIT_V(8); PG8_WAIT_L(0); PG8_BAR; PG8_MMA(0, 0, At, B0); PG8_MMA(0, 1, At, B1); PG8_BAR; PG8_SCHED;
            PG8_LDA(At, 0, 1); PG8_STAGE(PG8_SB(0, 0), b2, voffB); PG8_STAGE(PG8_SB(0, 1), b2 + hstepB, voffB); PG8_STAGE(PG8_SA(0, 0), a2, voffA);
            PG8_WAIT_V(8); PG8_WAIT_L(0); PG8_BAR; PG8_MMA(1, 0, At, B0); PG8_MMA(1, 1, At, B1); PG8_BAR; PG8_SCHED;
            PG8_LDB(B0, 1, 0); PG8_LDB(B1, 1, 1); PG8_SCHED; PG8_LDA(At, 1, 0); PG8_STAGE(PG8_SA(0, 1), a2 + hstepA, voffA);
            PG8_WAIT_V(8); PG8_WAIT_L(0); PG8_BAR; PG8_MMA(0, 0, At, B0); PG8_MMA(0, 1, At, B1); PG8_BAR; PG8_SCHED;
            PG8_LDA(At, 1, 1); PG8_STAGE(PG8_SB(1, 0), b3, voffB); PG8_STAGE(PG8_SB(1, 1), b3 + hstepB, voffB); PG8_STAGE(PG8_SA(1, 0), a3, voffA);
            PG8_WAIT_V(8); PG8_WAIT_L(0); PG8_BAR; PG8_MMA(1, 0, At, B0); PG8_MMA(1, 1, At, B1); PG8_BAR; PG8_SCHED;
            } else {
            PG8_LDB(B0, 0, 0); PG8_SCHED; PG8_LDA(At, 0, 0); PG8_STAGE(PG8_SA(1, 1), a1 + hstepA, voffA);
            PG8_WAIT_L(8); PG8_BAR; PG8_WAIT_L(0); PG8_MMA(0, 0, At, B0); PG8_BAR; PG8_SCHED;
            PG8_LDB(B1, 0, 1); PG8_STAGE(PG8_SB(0, 0), b2, voffB);
            PG8_BAR; PG8_WAIT_L(0); PG8_MMA(0, 1, At, B1); PG8_BAR;
            PG8_LDA(At, 0, 1); PG8_STAGE(PG8_SA(0, 0), a2, voffA);
            PG8_BAR; PG8_WAIT_L(0); PG8_MMA(1, 0, At, B0); PG8_BAR; PG8_SCHED;
            PG8_STAGE(PG8_SB(0, 1), b2 + hstepB, voffB);
            PG8_WAIT_V(6); PG8_BAR; PG8_MMA(1, 1, At, B1); PG8_BAR;
            PG8_LDB(B0, 1, 0); PG8_SCHED; PG8_LDA(At, 1, 0); PG8_STAGE(PG8_SA(0, 1), a2 + hstepA, voffA);
            PG8_WAIT_L(8); PG8_BAR; PG8_WAIT_L(0); PG8_MMA(0, 0, At, B0); PG8_BAR; PG8_SCHED;
            PG8_LDB(B1, 1, 1); PG8_STAGE(PG8_SB(1, 0), b3, voffB);
            PG8_BAR; PG8_WAIT_L(0); PG8_MMA(0, 1, At, B1); PG8_BAR;
            PG8_LDA(At, 1, 1); PG8_STAGE(PG8_SA(1, 0), a3, voffA);
            PG8_BAR; PG8_WAIT_L(0); PG8_MMA(1, 0, At, B0); PG8_BAR; PG8_SCHED;
            PG8_STAGE(PG8_SB(1, 1), b3 + hstepB, voffB);
            PG8_WAIT_V(6); PG8_BAR; PG8_MMA(1, 1, At, B1); PG8_BAR;
            }
        }
        if constexpr (ALIGN_EPI) { if (wr == 0) PG8_BAR; }
        if constexpr (!Epi::AFTER_DRAIN) { E(acc, cur, wr, wc, fr, fq); S.done(cur); }
        if (!has_next) break;
#pragma unroll
        for (int a = 0; a < 2; ++a)
#pragma unroll
            for (int b = 0; b < 2; ++b)
#pragma unroll
                for (int m = 0; m < 4; ++m)
#pragma unroll
                    for (int n = 0; n < 2; ++n) acc[a][b][m][n] = (f32x4){0.f, 0.f, 0.f, 0.f};
        cur = nxt; cA = nA; cB = nB; ++ui;
        if constexpr (ALIGN_EPI) { if (wr == 1) PG8_BAR; }
    }
    PG8_WAIT_V(0);
    if constexpr (!ALIGN_EPI) { if (wr == 0) PG8_BAR; }
    PG8_BAR;
    if constexpr (Epi::AFTER_DRAIN) { E.fused(acc, cur, wr, wc, fr, fq, lds, wid, lane); S.done(cur); }
#undef PG8_SA
#undef PG8_SB
#undef PG8_STAGE
#undef PG8_LDA
#undef PG8_LDB
#undef PG8_MMA
#undef PG8_WAIT_V
#undef PG8_WAIT_L
#undef PG8_BAR
#undef PG8_SCHED
}
}
#define GAS __attribute__((address_space(1)))
#define LAS __attribute__((address_space(3)))
typedef unsigned short bf16;
typedef unsigned v4u __attribute__((ext_vector_type(4)));
typedef float f32x4 __attribute__((ext_vector_type(4)));
typedef short bf16x8 __attribute__((ext_vector_type(8)));
typedef GAS unsigned gu32;
typedef GAS unsigned long long gu64;
#define RLX_AGENT __ATOMIC_RELAXED, __HIP_MEMORY_SCOPE_AGENT
#define LDS_WAIT() asm volatile("s_waitcnt lgkmcnt(0)" ::: "memory")
#define VM_WAIT() asm volatile("s_waitcnt vmcnt(0)" ::: "memory")
__device__ __forceinline__ unsigned long long rt() { return __builtin_amdgcn_s_memrealtime(); }
__device__ __forceinline__ unsigned f2bf(float f) { unsigned u = __builtin_bit_cast(unsigned, f); return (u + 0x7fffu + ((u >> 16) & 1u)) >> 16; }
__device__ __forceinline__ unsigned pk2(float lo, float hi) { return f2bf(lo) | (f2bf(hi) << 16); }
#define XB_TMO      128
#define XB_XCNT(j)  (256  + 64 * (j))
#define XB_XSUB(j)  (1280 + 64 * (j))
#define XB_XGEN(j)  (2304 + 64 * (j))
#define XB_TOP      3328
#define XB_TOPGEN   3392
#define XCD_BAR_WORDS 3456
#define XB_SPIN_CAP (1u << 18)

__device__ __forceinline__ unsigned xb_ld(unsigned* p)              { return __hip_atomic_load(p, __ATOMIC_RELAXED, __HIP_MEMORY_SCOPE_AGENT); }
__device__ __forceinline__ unsigned xb_add(unsigned* p, unsigned v) { return __hip_atomic_fetch_add(p, v, __ATOMIC_RELAXED, __HIP_MEMORY_SCOPE_AGENT); }
__device__ __forceinline__ unsigned xb_xcc_id() { return (unsigned)__builtin_amdgcn_s_getreg((3 << 11) | 20) & 0xFu; }
#define XB_SPIN(cond, bar) do { unsigned _sp = 0; while (cond) { __builtin_amdgcn_s_sleep(1); \
    if ((++_sp & 255u) == 0u) { if (xb_ld(&(bar)[XB_TMO])) break; if (_sp > XB_SPIN_CAP) { atomicAdd(&(bar)[XB_TMO], 1u); break; } } } } while (0)

struct XcdBarrier {
    unsigned* bar; unsigned x; unsigned w0;
    volatile LAS unsigned* st;
};

__device__ __forceinline__ XcdBarrier xcd_barrier_post(unsigned* bar, volatile LAS unsigned* st) {
    XcdBarrier b; b.bar = bar; b.x = xb_xcc_id(); b.st = st; b.w0 = (unsigned)__builtin_amdgcn_readfirstlane((int)(threadIdx.x >> 6)) == 0u ? 1u : 0u;
    if (threadIdx.x == 0) (void)xb_add(&bar[XB_XCNT(b.x)], 1u);
    return b;
}
__device__ __forceinline__ void xcd_barrier_complete(unsigned* bar, unsigned x, unsigned& nloc, unsigned& nx) {
    const unsigned G = gridDim.x * gridDim.y * gridDim.z;
    unsigned sum, cnt, mine, sp = 0u;
    for (;;) {
        sum = 0u; cnt = 0u; mine = 0u;
#pragma unroll
        for (unsigned j = 0; j < 16; ++j) { const unsigned c = xb_ld(&bar[XB_XCNT(j)]); sum += c; cnt += (c > 0u) ? 1u : 0u; mine = (j == x) ? c : mine; }
        if (sum == G) break;
        __builtin_amdgcn_s_sleep(1);
        if ((++sp & 255u) == 0u) { if (xb_ld(&bar[XB_TMO])) break; if (sp > XB_SPIN_CAP) { atomicAdd(&bar[XB_TMO], 1u); break; } }
    }
    nloc = mine > 0u ? mine : 1u; nx = cnt > 0u ? cnt : 1u;
}

__device__ __forceinline__ void xcd_barrier(const XcdBarrier& b) {
    asm volatile("s_waitcnt vmcnt(0)" ::: "memory");
    __syncthreads();
    unsigned zb_; asm volatile("v_mov_b32 %0, 0" : "=v"(zb_));
    if (b.w0 && __builtin_amdgcn_mbcnt_hi(~0u, __builtin_amdgcn_mbcnt_lo(~0u, zb_)) == 0u) {
        unsigned* bar = b.bar;
        __builtin_amdgcn_s_waitcnt(0);
        unsigned nloc = b.st[0], nx = b.st[1];
        if (nloc == 0u) { xcd_barrier_complete(bar, b.x, nloc, nx); b.st[0] = nloc; b.st[1] = nx; }
        const unsigned old = xb_add(&bar[XB_XSUB(b.x)], 1u);
        const unsigned gen = old / nloc;
        if (old + 1u == (gen + 1u) * nloc) {
            __builtin_amdgcn_fence(__ATOMIC_RELEASE, "agent");
            asm volatile("s_waitcnt vmcnt(0)" ::: "memory");
            const unsigned og = xb_add(&bar[XB_TOP], 1u);
            const unsigned tg = og / nx;
            if (og + 1u == (tg + 1u) * nx) xb_add(&bar[XB_TOPGEN], 1u);
            else XB_SPIN(xb_ld(&bar[XB_TOPGEN]) == tg, bar);
            __builtin_amdgcn_fence(__ATOMIC_ACQUIRE, "agent");
            xb_add(&bar[XB_XGEN(b.x)], 1u);
            asm volatile("s_waitcnt vmcnt(0)" ::: "memory");
        } else {
            XB_SPIN(xb_ld(&bar[XB_XGEN(b.x)]) == gen, bar);
            __builtin_amdgcn_fence(__ATOMIC_ACQUIRE, "agent");
            asm volatile("s_waitcnt vmcnt(0)" ::: "memory");
        }
    }
    __syncthreads();
}
constexpr int NB = 4, SEQ = 2048, M = NB * SEQ, DM = 4096, FF = 11008;
constexpr int QL = 1536, KVL = 512, A_IN = 2112, A_IN_PAD = 2304;
constexpr int MH = 32, DQK = 192, DVV = 128;
constexpr int UQ_N = MH * DQK;
constexpr int UKV_N = MH * 256;
constexpr int NG = 4, HPG = 8, NH = 32;
constexpr int SB_N = 10240;
constexpr int SB_K0 = 0, SB_V0 = 2304, SB_Q0 = 3840, SB_G0 = 9984;
constexpr int NCMP_PAD = 128;
constexpr float NORM_EPS = 1e-6f;
constexpr float QSCALE = 0.07216878364870322f * 1.4426950408889634f;
constexpr int NWAVES = 8;
#ifndef FFN_Q8_BOTH
#define FFN_Q8_BOTH 0
#endif
constexpr bool ffn_q8(int l) { return l == 1 || FFN_Q8_BOTH; }
constexpr int FFN_Q8_LAYER = 1;
#ifndef MK_ONE_LAUNCH
#define MK_ONE_LAUNCH 0
#endif

constexpr size_t MiB = 1u << 20;
constexpr size_t alignup(size_t x) { return (x + (MiB - 1)) & ~(MiB - 1); }
constexpr size_t WS_CTL = 0, CTL_ZERO_BYTES = 1 * MiB;
constexpr size_t WS_WA   = 1 * MiB;
constexpr size_t WS_WUQ  = WS_WA   + alignup((size_t)A_IN_PAD * DM * 2);
constexpr size_t WS_WUKV = WS_WUQ  + alignup((size_t)UQ_N * QL * 2);
constexpr size_t WS_WOA  = WS_WUKV + alignup((size_t)UKV_N * KVL * 2);
constexpr size_t WS_WFI  = WS_WOA  + alignup((size_t)DM * DM * 2);
constexpr size_t WFI_STRIDE = alignup((size_t)2 * FF * DM * 2);
constexpr size_t WS_WFO  = WS_WFI  + 2 * WFI_STRIDE;
constexpr size_t WFO_STRIDE = alignup((size_t)DM * FF * 2);
constexpr size_t WS_WSB  = WS_WFO  + 2 * WFO_STRIDE;
constexpr size_t WS_WOB  = WS_WSB  + alignup((size_t)SB_N * DM * 2);
constexpr size_t WS_W1K  = WS_WOB  + alignup((size_t)DM * DM * 2);
constexpr size_t WS_W2K  = WS_W1K  + alignup((size_t)192 * 6144 * 2);
constexpr size_t WS_W1V  = WS_W2K  + MiB;
constexpr size_t WS_W2V  = WS_W1V  + alignup((size_t)128 * 4096 * 2);
constexpr size_t WS_BIAS = WS_W2V  + MiB;
constexpr size_t WS_TABA = WS_BIAS + MiB;
constexpr size_t WS_TABB = WS_TABA + alignup((size_t)M * 32 * 8);
constexpr size_t WS_XN   = WS_TABB + alignup((size_t)M * 96 * 8);
constexpr size_t WS_UA   = WS_XN   + alignup((size_t)M * DM * 2);
constexpr size_t WS_CQ   = WS_UA   + alignup((size_t)M * A_IN_PAD * 4);
constexpr size_t WS_CKV  = WS_CQ   + alignup((size_t)M * QL * 2);
constexpr size_t WS_QA   = WS_CKV  + alignup((size_t)M * KVL * 2);
constexpr size_t WS_KA   = WS_QA   + alignup((size_t)M * UQ_N * 2);
constexpr size_t WS_VA   = WS_KA   + alignup((size_t)M * MH * DQK * 2);
constexpr size_t WS_OA   = WS_VA   + alignup((size_t)M * MH * DVV * 2);
constexpr size_t WS_H    = WS_OA   + alignup((size_t)M * DM * 2);
constexpr size_t WS_ACT  = WS_H    + alignup((size_t)M * DM * 4);
constexpr size_t WS_KB   = WS_ACT  + alignup((size_t)M * FF * 2);
constexpr size_t KB_BR   = (size_t)NB * NG * SEQ * DQK;
constexpr size_t WS_VB   = WS_KB   + alignup(3 * KB_BR * 2 + MiB);
constexpr size_t VB_BR   = (size_t)NB * NG * SEQ * DVV;
constexpr size_t WS_GATE = WS_VB   + alignup(3 * VB_BR * 2 + MiB);
constexpr size_t WS_HIDK = WS_GATE + alignup((size_t)M * 96 * 4);
constexpr size_t WS_HIDV = WS_HIDK + MiB;
constexpr size_t WS_KC   = WS_HIDV + MiB;
constexpr size_t WS_VC   = WS_KC   + MiB;
constexpr size_t WS_SEL  = WS_VC   + MiB;
constexpr size_t WS_OC   = WS_SEL  + MiB;
constexpr size_t WS_OS   = WS_OC   + alignup((size_t)M * DM * 4);
constexpr size_t WS_H2   = WS_OS   + alignup((size_t)M * DM * 4);
constexpr size_t WS_XN8  = WS_H2   + alignup((size_t)M * DM * 4);
constexpr size_t WS_SA   = WS_XN8  + alignup((size_t)M * DM);
constexpr size_t WS_END  = WS_SA   + MiB;

constexpr int CM_FFI = 10240, CM_WOA = 32256, CM_WOB = 36352, CM_WUQ = 40448, CM_WUKV = 46592, CM_FFI0 = 54784;
constexpr int CW_TMO = 0, CW_CODE = 1, CW_BAR = 4096, CW_NSAQ = 8192, CW_CMAX = 16384;

constexpr int RING_OFF = 0, RING_BYTES = 131072;
constexpr int LDSCTL_OFF = RING_BYTES, MISC_OFF = LDSCTL_OFF + 320;
constexpr int LDS_BYTES = 147456;
constexpr int ATT_K = 0, ATT_K2 = 24576, ATT_V = 49152, ATT_WS = 81920, ATT_IMP = 83968, ATT_SC = 116736, ATT_SELW = 120832;
typedef float f32x16 __attribute__((ext_vector_type(16)));
typedef float f32x2 __attribute__((ext_vector_type(2)));
typedef short s16x4 __attribute__((ext_vector_type(4)));
typedef unsigned long long u64;

__device__ __forceinline__ unsigned cvtpk(float lo, float hi) { unsigned r; asm volatile("v_cvt_pk_bf16_f32 %0, %1, %2" : "=v"(r) : "v"(lo), "v"(hi)); return r; }
__device__ __forceinline__ v4u pk8(f32x4 a, f32x4 b) { v4u w; w.x = cvtpk(a[0], a[1]); w.y = cvtpk(a[2], a[3]); w.z = cvtpk(b[0], b[1]); w.w = cvtpk(b[2], b[3]); return w; }
__device__ __forceinline__ float bf2f(bf16 b) { return __builtin_bit_cast(float, (unsigned)b << 16); }
__device__ __forceinline__ float fast_exp2(float x) { return __builtin_amdgcn_exp2f(x); }
__device__ __forceinline__ float sigmoidf_(float x) { return 1.f / (1.f + __expf(-x)); }
__device__ __forceinline__ float gelu_tanh(float x) { const float z = 0.7978845608028654f * (x + 0.044715f * x * x * x); return x / (1.f + __expf(-2.f * z)); }
__device__ __forceinline__ int crow(int r, int hi) { return (r & 3) + 8 * (r >> 2) + 4 * hi; }
#define SBAR() __builtin_amdgcn_sched_barrier(0)
template <int K> __device__ __forceinline__ float swz_xor(float v) { return __builtin_bit_cast(float, __builtin_amdgcn_ds_swizzle(__builtin_bit_cast(int, v), 0x1F | (K << 10))); }
__device__ __forceinline__ float half_max(float v) { auto rr = __builtin_amdgcn_permlane32_swap(__float_as_uint(v), __float_as_uint(v), false, false); return fmaxf(__uint_as_float(rr[0]), __uint_as_float(rr[1])); }
__device__ __forceinline__ float half_sum(float v) { auto rr = __builtin_amdgcn_permlane32_swap(__float_as_uint(v), __float_as_uint(v), false, false); return __uint_as_float(rr[0]) + __uint_as_float(rr[1]); }

__device__ __forceinline__ float wave_sum(float v) { v += swz_xor<1>(v); v += swz_xor<2>(v); v += swz_xor<4>(v); v += swz_xor<8>(v); v += swz_xor<16>(v); return half_sum(v); }
template <int K> __device__ __forceinline__ unsigned swz_xor_u(unsigned v) { return (unsigned)__builtin_amdgcn_ds_swizzle((int)v, 0x1F | (K << 10)); }

struct Frame {
    LAS unsigned char* lds;
    volatile LAS unsigned* MISC;
    gu32* ctl;
    int tid, lane, wave;
    int vcu, G;
    unsigned char* ws;
};

__device__ __forceinline__ int fresh_lane() { unsigned z; asm volatile("v_mov_b32 %0, 0" : "=v"(z)); return (int)__builtin_amdgcn_mbcnt_hi(~0u, __builtin_amdgcn_mbcnt_lo(~0u, z)); }
__device__ __forceinline__ int fresh_tid(int wave) { return wave * 64 + fresh_lane(); }
__device__ __forceinline__ void frame_fresh(Frame& F) { const int t = fresh_tid(F.wave); F.tid = t; F.lane = t & 63; }
template <class CM, class RM>
__device__ __forceinline__ void conv_item(const float* __restrict__ W, int Nsrc, const float* __restrict__ gain, bf16* WT, int K, int row_off, int nblk, LAS float* scr, int item, int lane, const CM& cm, const RM& rm) {
    const int kb = item / nblk, nb = item - kb * nblk, k0 = 64 * kb, n0 = 32 * nb;
    const int sc = cm(n0 + (lane & 31));
#pragma unroll 8
    for (int i = 0; i < 32; ++i) { const int kk = 2 * i + (lane >> 5); const int sr = rm(k0 + kk);
        float v = 0.f; if (sc >= 0) { v = W[(size_t)sr * Nsrc + sc]; if (gain) v *= gain[sr]; }
        scr[kk * 33 + (lane & 31)] = v; }
    LDS_WAIT(); asm volatile("" ::: "memory");
    const int c = lane & 7;
#pragma unroll
    for (int j = 0; j < 4; ++j) { const int n = (lane >> 3) + 8 * j; const LAS float* s = scr + (8 * c) * 33 + n;
        v4u o; o.x = pk2(s[0 * 33], s[1 * 33]); o.y = pk2(s[2 * 33], s[3 * 33]); o.z = pk2(s[4 * 33], s[5 * 33]); o.w = pk2(s[6 * 33], s[7 * 33]);
        *(GAS v4u*)(WT + (size_t)(row_off + n0 + n) * K + k0 + 8 * c) = o; }
    LDS_WAIT(); asm volatile("" ::: "memory");
}
template <class CM, class RM>
__device__ __forceinline__ void conv_matrix(Frame& F, const float* W, int Nsrc, const float* gain, bf16* WT, int K, int Ndst, int row_off, const CM& cm, const RM& rm) {
    LAS float* scr = (LAS float*)(F.lds + RING_OFF + F.wave * 8448);
    const int gw = F.vcu * NWAVES + F.wave, NGW = F.G * NWAVES;
    const int nblk = Ndst / 32, nitems = (K / 64) * nblk;
    for (int it = gw; it < nitems; it += NGW) conv_item(W, Nsrc, gain, WT, K, row_off, nblk, scr, it, F.lane, cm, rm);
}
__device__ __forceinline__ size_t wt_off(int n, int k, int K) { return ((size_t)(n >> 8) * (K >> 6) + (k >> 6)) * 16384 + (size_t)((n & 255) * 64 + (k & 63)); }
template <class IM>
__device__ __forceinline__ void conv_fast(Frame& F, const float* __restrict__ W, int Ksrc, int Nsrc, const float* __restrict__ gain, bf16* WT, int row_off, const IM& im) {
    LAS unsigned* scr = (LAS unsigned*)(F.lds + RING_OFF + F.wave * 8448);
    const int gw = F.vcu * NWAVES + F.wave, NGW = F.G * NWAVES, lane = F.lane;
    const int ncb = (Nsrc + 63) / 64, nitems = (Ksrc / 64) * ncb;
    const int q = lane & 15, r4 = lane >> 4;
    for (int it = gw; it < nitems; it += NGW) {
        const int nkb = Ksrc / 64, cb = it / nkb, kb = it - cb * nkb, k0 = 64 * kb, c0 = 64 * cb;
        const bool cok = c0 + 4 * q < Nsrc;
        f32x4 v[16];
        const GAS char* base = (const GAS char*)W + ((size_t)k0 * Nsrc + c0) * 4;
        const unsigned lo = ((unsigned)(2 * r4) * (unsigned)Nsrc + 4u * q) * 4u;
#pragma unroll
        for (int i = 0; i < 8; ++i) {
#pragma unroll
            for (int e = 0; e < 2; ++e) v[2 * i + e] = cok ? __builtin_nontemporal_load((const GAS f32x4*)(base + lo + (unsigned)((8 * i + e) * Nsrc) * 4u)) : (f32x4){0.f, 0.f, 0.f, 0.f}; }
#pragma unroll
        for (int i = 0; i < 8; ++i) { const int kr = k0 + 8 * i + 2 * r4; float g0 = 1.f, g1 = 1.f; if (gain) { g0 = gain[kr]; g1 = gain[kr + 1]; }
            const f32x4 a = v[2 * i] * g0, b = v[2 * i + 1] * g1; const int kp = 4 * i + r4;
#pragma unroll
            for (int j = 0; j < 4; ++j) scr[(4 * q + j) * 33 + kp] = cvtpk(a[j], b[j]); }
        LDS_WAIT(); asm volatile("" ::: "memory");
        const int ch = lane & 7;
#pragma unroll
        for (int jj = 0; jj < 8; ++jj) { const int c = (lane >> 3) + 8 * jj; const LAS unsigned* sp = scr + c * 33 + 4 * ch;
            v4u o; o.x = sp[0]; o.y = sp[1]; o.z = sp[2]; o.w = sp[3];
            const int n = (c0 + c < Nsrc) ? im(c0 + c) : -1;
            if (n >= 0) __builtin_nontemporal_store(o, (GAS v4u*)(WT + wt_off(row_off + n, k0 + 8 * ch, Ksrc))); }
        LDS_WAIT(); asm volatile("" ::: "memory");
    }
}
__device__ __forceinline__ void zero_rows(Frame& F, bf16* WT, int K, int r0, int r1) {
    const int kc = K / 8, n16 = (r1 - r0) * kc;
    for (int i = F.vcu * NWAVES * 64 + F.tid; i < n16; i += F.G * NWAVES * 64) { const int n = r0 + i / kc, c = i - (i / kc) * kc; *(GAS v4u*)(WT + wt_off(n, 8 * c, K)) = (v4u){0u, 0u, 0u, 0u}; }
}
struct InvUq { __device__ __forceinline__ int operator()(int c) const { const int h = c / 192, d = c - h * 192; const int dp = d < 128 ? d : 128 + 2 * ((d - 128) & 31) + ((d - 128) >> 5); return h * 192 + dp; } };
struct InvFfi { __device__ __forceinline__ int operator()(int c) const { const int p = c >= FF ? 1 : 0, cc = c - p * FF; return 256 * (cc >> 7) + 128 * p + (cc & 127); } };
__device__ __forceinline__ int nsa_dp(int d) { return d < 96 ? 2 * d : 2 * (d - 96) + 1; }
struct InvSkv { __device__ __forceinline__ int operator()(int c) const { const int kh = c / 320, e = c - kh * 320; return e < 192 ? kh * 192 + nsa_dp(e) : SB_V0 + kh * 128 + (e - 192); } };
struct InvBin { __device__ __forceinline__ int operator()(int c) const { if (c >= 6144) return c; const int h = c / 192, d = c - h * 192; return h * 192 + nsa_dp(d); } };
struct MapId { __device__ __forceinline__ int operator()(int n) const { return n; } };
struct MapLim { int lim; __device__ __forceinline__ int operator()(int n) const { return n < lim ? n : -1; } };
struct MapUq { __device__ __forceinline__ int operator()(int n) const { const int h = n / 192, dp = n - h * 192; const int d = dp < 128 ? dp : 128 + ((dp - 128) >> 1) + 32 * ((dp - 128) & 1); return h * 192 + d; } };
struct MapFfi { __device__ __forceinline__ int operator()(int n) const { const int t = n >> 8, p = (n >> 7) & 1, j = n & 127; return p * FF + 128 * t + j; } };
__device__ __forceinline__ int nsa_d(int dp) { return (dp >> 1) + 96 * (dp & 1); }
struct MapSkv { __device__ __forceinline__ int operator()(int n) const {
        if (n < SB_V0) { const int kh = n / 192, dp = n - kh * 192; return kh * 320 + nsa_d(dp); }
        const int c2 = n - SB_V0, kh = c2 >> 7, dv = c2 & 127; return kh * 320 + 192 + dv; } };
struct MapBin { __device__ __forceinline__ int operator()(int n) const {
        if (n < 6144) { const int h = n / 192, dp = n - h * 192; return h * 192 + nsa_d(dp); }
        return n < 6240 ? n : -1; } };
struct MapW1kRow { __device__ __forceinline__ int operator()(int k) const { const int l = k / 192, dp = k - l * 192; return l * 192 + nsa_d(dp); } };
struct MapW2kCol { __device__ __forceinline__ int operator()(int n) const { return nsa_d(n); } };

__device__ __forceinline__ u64 pack4(f32x4 v) { return (u64)cvtpk(v[0], v[1]) | ((u64)cvtpk(v[2], v[3]) << 32); }
__device__ __forceinline__ void norm_row_bf16(const float* xrow, bf16* orow, int lane) {
    const GAS f32x4* xr = (const GAS f32x4*)xrow + lane;
    f32x4 v[16]; float s = 0.f;
#pragma unroll
    for (int j = 0; j < 16; ++j) { v[j] = xr[64 * j]; s += (v[j].x * v[j].x + v[j].y * v[j].y) + (v[j].z * v[j].z + v[j].w * v[j].w); }
    const float r = 1.f / sqrtf(wave_sum(s) * (1.f / DM) + NORM_EPS);
    GAS u64* o8 = (GAS u64*)orow + lane;
#pragma unroll
    for (int j = 0; j < 16; ++j) o8[64 * j] = pack4(v[j] * r);
}
__device__ __forceinline__ void norm_phase(Frame& F, const float* X, bf16* XN) {
    const int gw = F.vcu * NWAVES + F.wave, NGW = F.G * NWAVES;
    for (int m = gw; m < M; m += NGW) norm_row_bf16(X + (size_t)m * DM, XN + (size_t)m * DM, F.lane);
}
__device__ __forceinline__ size_t wt8_off(int n, int k, int K) { return ((size_t)(n >> 8) * (K >> 7) + (k >> 7)) * 32768 + (size_t)((n & 255) * 128 + (k & 127)); }
template <class IM>
__device__ __forceinline__ void conv_colmax(Frame& F, const float* __restrict__ W, int Ksrc, int Nsrc, const float* __restrict__ gain, gu32* CMAX, int row_off, const IM& im) {
    const int gw = F.vcu * NWAVES + F.wave, NGW = F.G * NWAVES, lane = F.lane;
    const int ncb = (Nsrc + 63) / 64, nkb = Ksrc / 64, nitems = nkb * ncb;
    const int q = lane & 15, r4 = lane >> 4;
    for (int it = gw; it < nitems; it += NGW) {
        const int cb = it / nkb, kb = it - cb * nkb, k0 = 64 * kb, c0 = 64 * cb;
        const bool cok = c0 + 4 * q < Nsrc;
        const GAS char* base = (const GAS char*)W + ((size_t)k0 * Nsrc + c0) * 4;
        const unsigned lo = ((unsigned)(4 * r4) * (unsigned)Nsrc + 4u * q) * 4u;
        f32x4 v[16];
#pragma unroll
        for (int i = 0; i < 4; ++i)
#pragma unroll
            for (int e = 0; e < 4; ++e) v[4 * i + e] = cok ? __builtin_nontemporal_load((const GAS f32x4*)(base + lo + (unsigned)((16 * i + e) * Nsrc) * 4u)) : (f32x4){0.f, 0.f, 0.f, 0.f};
        f32x4 mx = {0.f, 0.f, 0.f, 0.f};
#pragma unroll
        for (int i = 0; i < 4; ++i)
#pragma unroll
            for (int e = 0; e < 4; ++e) { const float g = gain ? gain[k0 + 16 * i + 4 * r4 + e] : 1.f;
#pragma unroll
                for (int j = 0; j < 4; ++j) mx[j] = fmaxf(mx[j], fabsf(v[4 * i + e][j] * g)); }
#pragma unroll
        for (int j = 0; j < 4; ++j) { float m = mx[j]; m = fmaxf(m, swz_xor<16>(m)); m = half_max(m);
            const int c = c0 + 4 * q + j; const int n = (c < Nsrc) ? im(c) : -1;
            if (r4 == 0 && n >= 0) __hip_atomic_fetch_max(CMAX + row_off + n, __float_as_uint(m), __ATOMIC_RELAXED, __HIP_MEMORY_SCOPE_AGENT); }
    }
}
template <class IM>
__device__ __forceinline__ void conv_fast_q8(Frame& F, const float* __restrict__ W, int Ksrc, int Nsrc, const float* __restrict__ gain, signed char* WT8, const gu32* CMAX, int row_off, const IM& im) {
    LAS unsigned* scr = (LAS unsigned*)(F.lds + RING_OFF + F.wave * 8448);
    const int gw = F.vcu * NWAVES + F.wave, NGW = F.G * NWAVES, lane = F.lane;
    const int ncb = (Nsrc + 63) / 64, nkb = Ksrc / 64, nitems = nkb * ncb;
    const int q = lane & 15, r4 = lane >> 4;
    for (int it = gw; it < nitems; it += NGW) {
        const int cb = it / nkb, kb = it - cb * nkb, k0 = 64 * kb, c0 = 64 * cb;
        const bool cok = c0 + 4 * q < Nsrc;
        const GAS char* base = (const GAS char*)W + ((size_t)k0 * Nsrc + c0) * 4;
        const unsigned lo = ((unsigned)(4 * r4) * (unsigned)Nsrc + 4u * q) * 4u;
        f32x4 v[16];
#pragma unroll
        for (int i = 0; i < 4; ++i)
#pragma unroll
            for (int e = 0; e < 4; ++e) v[4 * i + e] = cok ? __builtin_nontemporal_load((const GAS f32x4*)(base + lo + (unsigned)((16 * i + e) * Nsrc) * 4u)) : (f32x4){0.f, 0.f, 0.f, 0.f};
        f32x4 qs;
#pragma unroll
        for (int j = 0; j < 4; ++j) { const int c = c0 + 4 * q + j; const int n = (c < Nsrc) ? im(c) : -1; const float cm = n >= 0 ? __uint_as_float(__hip_atomic_load(CMAX + row_off + n, __ATOMIC_RELAXED, __HIP_MEMORY_SCOPE_AGENT)) : 0.f; qs[j] = cm > 0.f ? 127.f / cm : 0.f; }
#pragma unroll
        for (int i = 0; i < 4; ++i) { unsigned pk[4] = {0u, 0u, 0u, 0u};
#pragma unroll
            for (int e = 0; e < 4; ++e) { const float g = gain ? gain[k0 + 16 * i + 4 * r4 + e] : 1.f;
#pragma unroll
                for (int j = 0; j < 4; ++j) { const int qi = (int)rintf(v[4 * i + e][j] * g * qs[j]); pk[j] |= ((unsigned)qi & 0xffu) << (8 * e); } }
#pragma unroll
            for (int j = 0; j < 4; ++j) scr[(4 * q + j) * 17 + 4 * i + r4] = pk[j]; }
        LDS_WAIT(); asm volatile("" ::: "memory");
        const int ch = lane & 3;
#pragma unroll
        for (int jj = 0; jj < 4; ++jj) { const int c = (lane >> 2) + 16 * jj; const LAS unsigned* sp = scr + c * 17 + 4 * ch;
            v4u o; o.x = sp[0]; o.y = sp[1]; o.z = sp[2]; o.w = sp[3];
            const int n = (c0 + c < Nsrc) ? im(c0 + c) : -1;
            if (n >= 0) *(GAS v4u*)((GAS char*)WT8 + wt8_off(row_off + n, k0 + 16 * ch, Ksrc)) = o; }
        LDS_WAIT(); asm volatile("" ::: "memory");
    }
}
__device__ __forceinline__ void zero_rows8(Frame& F, signed char* WT8, int K, int r0, int r1) {
    const int kc = K / 16, n16 = (r1 - r0) * kc;
    for (int i = F.vcu * NWAVES * 64 + F.tid; i < n16; i += F.G * NWAVES * 64) { const int n = r0 + i / kc, c = i - (i / kc) * kc; *(GAS v4u*)((GAS char*)WT8 + wt8_off(n, 16 * c, K)) = (v4u){0u, 0u, 0u, 0u}; }
}
__device__ __forceinline__ void norm_phase_q8(Frame& F, const float* X, signed char* XN8, float* SA) {
    const int gw = F.vcu * NWAVES + F.wave, NGW = F.G * NWAVES;
    for (int m = gw; m < M; m += NGW) {
        const GAS f32x4* xr = (const GAS f32x4*)(X + (size_t)m * DM) + F.lane;
        f32x4 v[16]; float s = 0.f, am = 0.f;
#pragma unroll
        for (int j = 0; j < 16; ++j) { v[j] = xr[64 * j]; s += (v[j].x * v[j].x + v[j].y * v[j].y) + (v[j].z * v[j].z + v[j].w * v[j].w);
            am = fmaxf(am, fmaxf(fmaxf(fabsf(v[j].x), fabsf(v[j].y)), fmaxf(fabsf(v[j].z), fabsf(v[j].w)))); }
        const float r = 1.f / sqrtf(wave_sum(s) * (1.f / DM) + NORM_EPS);
        am = fmaxf(am, swz_xor<1>(am)); am = fmaxf(am, swz_xor<2>(am)); am = fmaxf(am, swz_xor<4>(am)); am = fmaxf(am, swz_xor<8>(am)); am = fmaxf(am, swz_xor<16>(am)); am = half_max(am);
        const float qs = am > 0.f ? 127.f / am : 0.f;
        if (F.lane == 0) SA[m] = am * r * (1.f / 127.f);
        GAS unsigned* o4 = (GAS unsigned*)(XN8 + (size_t)m * DM) + F.lane;
#pragma unroll
        for (int j = 0; j < 16; ++j) { const int a = (int)rintf(v[j].x * qs), b = (int)rintf(v[j].y * qs), c = (int)rintf(v[j].z * qs), d = (int)rintf(v[j].w * qs);
            o4[64 * j] = ((unsigned)a & 0xffu) | (((unsigned)b & 0xffu) << 8) | (((unsigned)c & 0xffu) << 16) | (((unsigned)d & 0xffu) << 24); }
    }
}
__device__ __forceinline__ void quant_rows_phase(Frame& F, const bf16* X, signed char* Q8, float* SA) {
    const int gw = F.vcu * NWAVES + F.wave, NGW = F.G * NWAVES;
    for (int m = gw; m < M; m += NGW) {
        const GAS v4u* xr = (const GAS v4u*)(X + (size_t)m * DM) + F.lane;
        v4u w[8]; float am = 0.f;
#pragma unroll
        for (int j = 0; j < 8; ++j) w[j] = xr[64 * j];
#pragma unroll
        for (int j = 0; j < 8; ++j) {
#pragma unroll
            for (int e = 0; e < 4; ++e) { const unsigned u = w[j][e]; am = fmaxf(am, fmaxf(fabsf(__uint_as_float(u << 16)), fabsf(__uint_as_float(u & 0xffff0000u)))); } }
        am = fmaxf(am, swz_xor<1>(am)); am = fmaxf(am, swz_xor<2>(am)); am = fmaxf(am, swz_xor<4>(am)); am = fmaxf(am, swz_xor<8>(am)); am = fmaxf(am, swz_xor<16>(am)); am = half_max(am);
        const float qs = am > 0.f ? 127.f / am : 0.f;
        if (F.lane == 0) SA[m] = am * (1.f / 127.f);
        GAS u64* o8 = (GAS u64*)(Q8 + (size_t)m * DM) + F.lane;
#pragma unroll
        for (int j = 0; j < 8; ++j) { u64 o = 0;
#pragma unroll
            for (int e = 0; e < 4; ++e) { const unsigned u = w[j][e]; const int a = (int)rintf(__uint_as_float(u << 16) * qs), b = (int)rintf(__uint_as_float(u & 0xffff0000u) * qs);
                o |= (u64)(((unsigned)a & 0xffu) | (((unsigned)b & 0xffu) << 8)) << (16 * e); }
            o8[64 * j] = o; }
    }
}
__device__ __forceinline__ void final_norm_phase(Frame& F, const float* X, const float* g, float* out) {
    const int gw = F.vcu * NWAVES + F.wave, NGW = F.G * NWAVES;
    for (int m = gw; m < M; m += NGW) {
        const GAS f32x4* xr = (const GAS f32x4*)(X + (size_t)m * DM) + F.lane; const GAS f32x4* gr = (const GAS f32x4*)g + F.lane;
        f32x4 v[16]; float s = 0.f;
#pragma unroll
        for (int j = 0; j < 16; ++j) { v[j] = xr[64 * j]; s += (v[j].x * v[j].x + v[j].y * v[j].y) + (v[j].z * v[j].z + v[j].w * v[j].w); }
        const float r = 1.f / sqrtf(wave_sum(s) * (1.f / DM) + NORM_EPS);
        GAS f32x4* o = (GAS f32x4*)(out + (size_t)m * DM) + F.lane;
#pragma unroll
        for (int j = 0; j < 16; ++j) o[64 * j] = v[j] * r * gr[64 * j];
    }
}
__device__ __forceinline__ void rope_tables(Frame& F, const int* pos, f32x2* tabA, f32x2* tabB) {
    const int gt = F.vcu * NWAVES * 64 + F.tid, NT = F.G * NWAVES * 64;
    for (int e = gt; e < M * 128; e += NT) {
        const int tok = e >> 7, j = e & 127;
        const bool isA = j < 32; const int i = isA ? j : j - 32; const float d = isA ? 64.f : 192.f;
        const float inv = powf(10000.f, -(float)(2 * i) / d);
        const float ang = (float)pos[tok] * inv;
        const double rev = (double)ang * 0.15915494309189535; const float fr = (float)(rev - floor(rev));
        f32x2 cs; cs.x = __builtin_amdgcn_cosf(fr); cs.y = __builtin_amdgcn_sinf(fr);
        if (isA) tabA[(size_t)tok * 32 + i] = cs; else tabB[(size_t)tok * 96 + i] = cs;
    }
}
__device__ __forceinline__ void pe_bias(Frame& F, const float* pe, const float* W1, int K, int N, float* bias) {
    const int gw = F.vcu * NWAVES + F.wave, NGW = F.G * NWAVES;
    for (int n = NGW - 1 - gw; n < N; n += NGW) {
        float s = 0.f;
        for (int k0 = F.lane; k0 < K; k0 += 64 * 16) { float w[16], p[16];
#pragma unroll
            for (int u = 0; u < 16; ++u) { const int k = k0 + 64 * u; const bool ok = k < K; w[u] = ok ? W1[(size_t)k * N + n] : 0.f; p[u] = ok ? pe[k] : 0.f; }
#pragma unroll
            for (int u = 0; u < 16; ++u) s += p[u] * w[u]; }
        s = wave_sum(s); if (F.lane == 0) bias[n] = s; }
}
__device__ __forceinline__ unsigned q8x4(f32x4 v, float qs) { const int a = (int)rintf(v.x * qs), b = (int)rintf(v.y * qs), c = (int)rintf(v.z * qs), d = (int)rintf(v.w * qs);
    return ((unsigned)a & 0xffu) | (((unsigned)b & 0xffu) << 8) | (((unsigned)c & 0xffu) << 16) | (((unsigned)d & 0xffu) << 24); }
__device__ __forceinline__ float wave_max(float v) { v = fmaxf(v, swz_xor<1>(v)); v = fmaxf(v, swz_xor<2>(v)); v = fmaxf(v, swz_xor<4>(v)); v = fmaxf(v, swz_xor<8>(v)); v = fmaxf(v, swz_xor<16>(v)); return half_max(v); }
__device__ __forceinline__ float amax4(f32x4 v) { return fmaxf(fmaxf(fabsf(v.x), fabsf(v.y)), fmaxf(fabsf(v.z), fabsf(v.w))); }
__device__ __forceinline__ void mla_latent_phase(Frame& F, const float* UA, signed char* CQ8, signed char* CKV8, float* SAq, float* SAkv, bf16* KA, const f32x2* tabA) {
    const int gw = F.vcu * NWAVES + F.wave, NGW = F.G * NWAVES; const int lane = F.lane;
    for (int m = gw; m < M; m += NGW) {
        const float* u = UA + (size_t)m * A_IN_PAD;
        const GAS f32x4* uq = (const GAS f32x4*)u + lane; const GAS f32x4* uk = (const GAS f32x4*)(u + QL) + lane;
        const int i = lane & 31;
        f32x4 q[6], kv[2];
#pragma unroll
        for (int j = 0; j < 6; ++j) q[j] = uq[64 * j];
#pragma unroll
        for (int j = 0; j < 2; ++j) kv[j] = uk[64 * j];
        const float x1 = u[QL + KVL + i], x2 = u[QL + KVL + 32 + i]; const f32x2 cs = tabA[(size_t)m * 32 + i];
        float s = 0.f, s2 = 0.f, aq = 0.f, ak = 0.f;
#pragma unroll
        for (int j = 0; j < 6; ++j) { s += (q[j].x * q[j].x + q[j].y * q[j].y) + (q[j].z * q[j].z + q[j].w * q[j].w); aq = fmaxf(aq, amax4(q[j])); }
#pragma unroll
        for (int j = 0; j < 2; ++j) { s2 += (kv[j].x * kv[j].x + kv[j].y * kv[j].y) + (kv[j].z * kv[j].z + kv[j].w * kv[j].w); ak = fmaxf(ak, amax4(kv[j])); }
        const float rq = 1.f / sqrtf(wave_sum(s) * (1.f / QL) + NORM_EPS), rk = 1.f / sqrtf(wave_sum(s2) * (1.f / KVL) + NORM_EPS);
        aq = wave_max(aq); ak = wave_max(ak);
        const float qsq = aq > 0.f ? 127.f / aq : 0.f, qsk = ak > 0.f ? 127.f / ak : 0.f;
        if (lane == 0) { SAq[m] = aq * rq * (1.f / 127.f); SAkv[m] = ak * rk * (1.f / 127.f); }
        GAS unsigned* oq = (GAS unsigned*)(CQ8 + (size_t)m * QL) + lane;
#pragma unroll
        for (int j = 0; j < 6; ++j) oq[64 * j] = q8x4(q[j], qsq);
        GAS unsigned* ok = (GAS unsigned*)(CKV8 + (size_t)m * KVL) + lane;
#pragma unroll
        for (int j = 0; j < 2; ++j) ok[64 * j] = q8x4(kv[j], qsk);
        const unsigned pk = cvtpk(x1 * cs.x - x2 * cs.y, x2 * cs.x + x1 * cs.y);
        const int b = m >> 11, sq = m & 2047, h0 = (lane >> 5) * 16;
#pragma unroll 4
        for (int h = 0; h < 16; ++h) *(GAS unsigned*)(KA + ((size_t)((b * MH + h0 + h) * SEQ + sq)) * DQK + 128 + 2 * i) = pk;
    }
}
template <class Fn> struct EpiRow8 {
    static constexpr bool PERM = true, AFTER_DRAIN = false; Fn f;
    __device__ __forceinline__ void operator()(const pg8::f32x4 (&acc)[2][2][4][2], const pg8::Unit& u, int wr, int wc, int fr, int fq) const {
        const int row0 = u.pm * 256 + wr * 64 + fr, col0 = u.pn * 256 + wc * 32 + 8 * fq;
#pragma unroll
        for (int ai = 0; ai < 2; ++ai)
#pragma unroll
            for (int m = 0; m < 4; ++m)
#pragma unroll
                for (int bj = 0; bj < 2; ++bj) f(row0 + ai * 128 + m * 16, col0 + bj * 128, acc[ai][bj][m][0], acc[ai][bj][m][1]);
    }
};
template <class Fn> struct EpiGate {
    static constexpr bool PERM = true, AFTER_DRAIN = false; Fn f;
    __device__ __forceinline__ void operator()(const pg8::f32x4 (&acc)[2][2][4][2], const pg8::Unit& u, int wr, int wc, int fr, int fq) const {
        const int row0 = u.pm * 256 + wr * 64 + fr, col0 = u.pn * 128 + wc * 32 + 8 * fq;
#pragma unroll
        for (int ai = 0; ai < 2; ++ai)
#pragma unroll
            for (int m = 0; m < 4; ++m) f(row0 + ai * 128 + m * 16, col0, acc[ai][0][m][0], acc[ai][0][m][1], acc[ai][1][m][0], acc[ai][1][m][1]);
    }
};
__device__ __forceinline__ void rope4r(f32x4& v0, f32x4& v1, const f32x4 t0, const f32x4 t1) {
    f32x4 a, b;
    a.x = v0.x * t0.x - v0.y * t0.y; a.y = v0.y * t0.x + v0.x * t0.y; a.z = v0.z * t0.z - v0.w * t0.w; a.w = v0.w * t0.z + v0.z * t0.w;
    b.x = v1.x * t1.x - v1.y * t1.y; b.y = v1.y * t1.x + v1.x * t1.y; b.z = v1.z * t1.z - v1.w * t1.w; b.w = v1.w * t1.z + v1.z * t1.w;
    v0 = a; v1 = b;
}
__device__ __forceinline__ void rope4(f32x4& v0, f32x4& v1, const f32x2* t) {
    const f32x4 t0 = *(const GAS f32x4*)t, t1 = *(const GAS f32x4*)(t + 2);
    f32x4 a, b;
    a.x = v0.x * t0.x - v0.y * t0.y; a.y = v0.y * t0.x + v0.x * t0.y; a.z = v0.z * t0.z - v0.w * t0.w; a.w = v0.w * t0.z + v0.z * t0.w;
    b.x = v1.x * t1.x - v1.y * t1.y; b.y = v1.y * t1.x + v1.x * t1.y; b.z = v1.z * t1.z - v1.w * t1.w; b.w = v1.w * t1.z + v1.z * t1.w;
    v0 = a; v1 = b;
}
#define GOFF(T, base, byteoff) (*(GAS T*)((GAS char*)(base) + (byteoff)))
struct FnUA { float* UA; __device__ __forceinline__ void operator()(int row, int col, f32x4 v0, f32x4 v1) const {
        if (col < A_IN) { const unsigned o = ((unsigned)row * A_IN_PAD + col) * 4u; GOFF(f32x4, UA, o) = v0; GOFF(f32x4, UA, o + 16u) = v1; } } };
struct FnQa { bf16* QA; const f32x2* tab; __device__ __forceinline__ void operator()(int row, int col, f32x4 v0, f32x4 v1) const {
        const int h = col / 192, d = col - h * 192;
        if (d >= 128) { const unsigned to = ((unsigned)row * 32 + ((d - 128) >> 1)) * 8u; rope4(v0, v1, (const f32x2*)((const GAS char*)tab + to)); }
        GOFF(v4u, QA, ((unsigned)row * UQ_N + col) * 2u) = pk8(v0 * QSCALE, v1 * QSCALE); } };
struct FnKVa { bf16* KA; bf16* VA; __device__ __forceinline__ void operator()(int row, int col, f32x4 v0, f32x4 v1) const {
        const int h = col >> 8, j = col & 255, b = row >> 11, s = row & 2047; const unsigned r = (unsigned)(b * MH + h) * SEQ + s;
        if (j < 128) GOFF(v4u, KA, (r * DQK + j) * 2u) = pk8(v0, v1); else GOFF(v4u, VA, (r * DVV + (j - 128)) * 2u) = pk8(v0, v1); } };
struct FnResNew { const float* X; float* H; __device__ __forceinline__ void operator()(int row, int col, f32x4 v0, f32x4 v1) const {
        const unsigned o = ((unsigned)row * DM + col) * 4u; const f32x4 x0 = GOFF(const f32x4, X, o), x1 = GOFF(const f32x4, X, o + 16u);
        GOFF(f32x4, H, o) = x0 + v0; GOFF(f32x4, H, o + 16u) = x1 + v1; } };
__device__ __forceinline__ float swiglu1(float a, float b) { return a * b * __builtin_amdgcn_rcpf(1.f + __builtin_amdgcn_exp2f(-1.4426950408889634f * a)); }
struct FnSwiglu { bf16* ACT; __device__ __forceinline__ void operator()(int row, int col, f32x4 a0, f32x4 a1, f32x4 b0, f32x4 b1) const {
        f32x4 r0, r1;
#pragma unroll
        for (int i = 0; i < 4; ++i) { r0[i] = swiglu1(a0[i], b0[i]); r1[i] = swiglu1(a1[i], b1[i]); }
        GOFF(v4u, ACT, (((unsigned)(row >> 8) * (FF / 64) + (unsigned)(col >> 6)) * 16384u + (unsigned)((row & 255) * 64 + (col & 63))) * 2u) = pk8(r0, r1); } };
template <class Inner> struct EpiI8 {
    static constexpr bool PERM = true, AFTER_DRAIN = false; Inner E; const float* SA; const gu32* CMAX;
    __device__ __forceinline__ void operator()(const pg8::f32x4 (&acc_c)[2][2][4][2], const pg8::Unit& u, int wr, int wc, int fr, int fq) const {
        pg8::f32x4 (&acc)[2][2][4][2] = const_cast<pg8::f32x4 (&)[2][2][4][2]>(acc_c);
        const int row0 = u.pm * 256 + wr * 64 + fr, col0 = u.pn * 256 + wc * 32 + 8 * fq;
        f32x4 sw[2][2];
#pragma unroll
        for (int bj = 0; bj < 2; ++bj)
#pragma unroll
            for (int n = 0; n < 2; ++n) { const v4u b = *(const GAS v4u*)(CMAX + col0 + bj * 128 + 4 * n);
                sw[bj][n] = (f32x4){__uint_as_float(b.x), __uint_as_float(b.y), __uint_as_float(b.z), __uint_as_float(b.w)} * (1.f / 127.f); }
#pragma unroll
        for (int ai = 0; ai < 2; ++ai)
#pragma unroll
            for (int m = 0; m < 4; ++m) { const float sa = SA[row0 + ai * 128 + m * 16];
#pragma unroll
                for (int bj = 0; bj < 2; ++bj)
#pragma unroll
                    for (int n = 0; n < 2; ++n) { const pg8::i32x4_t iv = __builtin_bit_cast(pg8::i32x4_t, acc[ai][bj][m][n]);
                        acc[ai][bj][m][n] = (f32x4){(float)iv.x, (float)iv.y, (float)iv.z, (float)iv.w} * sw[bj][n] * sa; } }
        E(acc, u, wr, wc, fr, fq);
    }
};
struct EpiSB {
    static constexpr bool PERM = true, AFTER_DRAIN = false;
    bf16* KB; bf16* VB; bf16* QB; float* GATE; const f32x2* tab;
    __device__ __forceinline__ void operator()(const pg8::f32x4 (&acc)[2][2][4][2], const pg8::Unit& u, int wr, int wc, int fr, int fq) const {
        const int row0 = u.pm * 256 + wr * 64 + fr, cl = wc * 32 + 8 * fq;
        const int b = row0 >> 11, s0 = row0 & 2047;
        if (u.pn < 9) {
#pragma unroll
            for (int bj = 0; bj < 2; ++bj) { const int col = u.pn * 256 + bj * 128 + cl, kh = col / 192, dp = col - kh * 192, br = kh >> 2, g = kh & 3;
                const unsigned ob = ((unsigned)br * (unsigned)KB_BR + ((unsigned)((b * NG + g) * SEQ + s0)) * DQK + dp) * 2u, tb = ((unsigned)row0 * 96 + (dp >> 1)) * 8u;
#pragma unroll
                for (int ai = 0; ai < 2; ++ai) { f32x4 t0[4], t1[4];
#pragma unroll
                    for (int m = 0; m < 4; ++m) { const GAS char* tp = (const GAS char*)tab + tb + (unsigned)(ai * 128 + m * 16) * 768u; t0[m] = *(const GAS f32x4*)tp; t1[m] = *(const GAS f32x4*)(tp + 16); }
#pragma unroll
                    for (int m = 0; m < 4; ++m) { const unsigned ro = ai * 128 + m * 16; f32x4 v0 = acc[ai][bj][m][0], v1 = acc[ai][bj][m][1];
                        rope4r(v0, v1, t0[m], t1[m]); GOFF(v4u, KB, ob + ro * (DQK * 2u)) = pk8(v0, v1); }
                    SBAR(); } }
        } else if (u.pn < 15) {
#pragma unroll
            for (int bj = 0; bj < 2; ++bj) { const int c2 = (u.pn - 9) * 256 + bj * 128 + cl, kh = c2 >> 7, dv = c2 & 127, br = kh >> 2, g = kh & 3;
                const unsigned ob = ((unsigned)br * (unsigned)VB_BR + ((unsigned)((b * NG + g) * SEQ + s0)) * DVV + dv) * 2u;
#pragma unroll
                for (int ai = 0; ai < 2; ++ai)
#pragma unroll
                    for (int m = 0; m < 4; ++m) { const unsigned ro = ai * 128 + m * 16; GOFF(v4u, VB, ob + ro * (DVV * 2u)) = pk8(acc[ai][bj][m][0], acc[ai][bj][m][1]); } }
        } else if (u.pn < 39) {
#pragma unroll
            for (int bj = 0; bj < 2; ++bj) { const int c3 = (u.pn - 15) * 256 + bj * 128 + cl, h = c3 / 192, dp = c3 - h * 192;
                const unsigned ob = ((unsigned)row0 * UQ_N + c3) * 2u, tb = ((unsigned)row0 * 96 + (dp >> 1)) * 8u;
#pragma unroll
                for (int ai = 0; ai < 2; ++ai) { f32x4 t0[4], t1[4];
#pragma unroll
                    for (int m = 0; m < 4; ++m) { const GAS char* tp = (const GAS char*)tab + tb + (unsigned)(ai * 128 + m * 16) * 768u; t0[m] = *(const GAS f32x4*)tp; t1[m] = *(const GAS f32x4*)(tp + 16); }
#pragma unroll
                    for (int m = 0; m < 4; ++m) { const unsigned ro = ai * 128 + m * 16; f32x4 v0 = acc[ai][bj][m][0], v1 = acc[ai][bj][m][1];
                        rope4r(v0, v1, t0[m], t1[m]); GOFF(v4u, QB, ob + ro * (UQ_N * 2u)) = pk8(v0 * QSCALE, v1 * QSCALE); }
                    SBAR(); } }
        } else {
            if (cl < 96) {
                const unsigned ob = ((unsigned)row0 * 96 + cl) * 4u;
#pragma unroll
                for (int ai = 0; ai < 2; ++ai)
#pragma unroll
                    for (int m = 0; m < 4; ++m) { const unsigned ro = ai * 128 + m * 16; f32x4 g0, g1;
#pragma unroll
                        for (int i = 0; i < 4; ++i) { g0[i] = sigmoidf_(acc[ai][0][m][0][i]); g1[i] = sigmoidf_(acc[ai][0][m][1][i]); }
                        GOFF(f32x4, GATE, ob + ro * 384u) = g0; GOFF(f32x4, GATE, ob + ro * 384u + 16u) = g1; }
            }
        }
    }
};
__device__ __forceinline__ int v_st(int k, int c) { const int kk = (k & ~0xC) | ((k & 4) << 1) | ((k & 8) >> 1); return ((kk >> 3) * 4 + (c >> 5)) * 512 + ((kk & 7) * 32 + (c & 31)) * 2; }
__device__ __forceinline__ int v_rd_base(int lane) { return ((lane & 3) << 3) | (((lane >> 2) & 3) << 6) | (((lane >> 4) & 1) << 5) | (((lane >> 5) & 1) << 8); }
constexpr int v_rd_off(int d0, int ks, int half) { return d0 * 512 + ks * 4096 + half * 2048; }

__device__ __forceinline__ void qkt(f32x16& p0, f32x16& p1, LAS unsigned char* Kl, int r32, int hi, const bf16x8 (&qf)[12]) {
    p0 = (f32x16){}; p1 = (f32x16){};
    const int sw = (r32 >> 1) & 7;
    LAS unsigned char* kb[4];
#pragma unroll
    for (int k4 = 0; k4 < 4; ++k4) kb[k4] = Kl + r32 * 128 + (((2 * k4 + hi) ^ sw) << 4);
#pragma unroll
    for (int ks = 0; ks < 12; ++ks) { LAS unsigned char* a = kb[ks & 3] + (ks >> 2) * 8192;
        const bf16x8 b0 = *(const LAS bf16x8*)a, b1 = *(const LAS bf16x8*)(a + 4096);
        p0 = __builtin_amdgcn_mfma_f32_32x32x16_bf16(b0, qf[ks], p0, 0, 0, 0);
        p1 = __builtin_amdgcn_mfma_f32_32x32x16_bf16(b1, qf[ks], p1, 0, 0, 0); }
}
__device__ __forceinline__ void pv_tile(f32x16 (&o)[4], unsigned vb0, bf16x8 pa0, bf16x8 pa1, bf16x8 pa2, bf16x8 pa3) {
#define TRRD(dst, off) asm volatile("ds_read_b64_tr_b16 %0, %1 offset:%2" : "=&v"(dst) : "v"(vb0), "i"(off) : "memory")
#define PV_D0(d0) do { s16x4 l0, l1, l2, l3, h0, h1, h2, h3; constexpr int b_ = v_rd_off(d0, 0, 0); \
        TRRD(l0, b_); TRRD(h0, b_ + 2048); TRRD(l1, b_ + 4096); TRRD(h1, b_ + 6144); TRRD(l2, b_ + 8192); TRRD(h2, b_ + 10240); TRRD(l3, b_ + 12288); TRRD(h3, b_ + 14336); \
        asm volatile("s_waitcnt lgkmcnt(0)" ::: "memory"); SBAR(); \
        o[d0] = __builtin_amdgcn_mfma_f32_32x32x16_bf16((bf16x8){l0[0], l0[1], l0[2], l0[3], h0[0], h0[1], h0[2], h0[3]}, pa0, o[d0], 0, 0, 0); \
        o[d0] = __builtin_amdgcn_mfma_f32_32x32x16_bf16((bf16x8){l1[0], l1[1], l1[2], l1[3], h1[0], h1[1], h1[2], h1[3]}, pa1, o[d0], 0, 0, 0); \
        o[d0] = __builtin_amdgcn_mfma_f32_32x32x16_bf16((bf16x8){l2[0], l2[1], l2[2], l2[3], h2[0], h2[1], h2[2], h2[3]}, pa2, o[d0], 0, 0, 0); \
        o[d0] = __builtin_amdgcn_mfma_f32_32x32x16_bf16((bf16x8){l3[0], l3[1], l3[2], l3[3], h3[0], h3[1], h3[2], h3[3]}, pa3, o[d0], 0, 0, 0); } while (0)
    PV_D0(0); PV_D0(1); PV_D0(2); PV_D0(3);
#undef PV_D0
#undef TRRD
}
__device__ __forceinline__ void pack_p(const f32x16& p0, const f32x16& p1, bf16x8& pa0, bf16x8& pa1, bf16x8& pa2, bf16x8& pa3) {
#define PK4(P, B_, OUT) do { unsigned a0 = cvtpk(P[B_+0], P[B_+1]), a1 = cvtpk(P[B_+2], P[B_+3]); unsigned b0 = cvtpk(P[B_+4], P[B_+5]), b1 = cvtpk(P[B_+6], P[B_+7]); \
        auto r0 = __builtin_amdgcn_permlane32_swap(a0, b0, false, false); auto r1 = __builtin_amdgcn_permlane32_swap(a1, b1, false, false); \
        v4u w = {r0[0], r1[0], r0[1], r1[1]}; OUT = __builtin_bit_cast(bf16x8, w); } while (0)
    PK4(p0, 0, pa0); PK4(p0, 8, pa1); PK4(p1, 0, pa2); PK4(p1, 8, pa3);
#undef PK4
}
__device__ __forceinline__ void mask_tile(f32x16& p0, f32x16& p1, int kb0, int hi, int klo, int khi, bool lb) {
    const float NEG = -__builtin_inff();
    const int dl = klo - kb0 - 4 * hi; const int dh = lb ? khi - kb0 - 4 * hi : -1000000;
#pragma unroll
    for (int r = 0; r < 16; ++r) { const int c = (r & 3) + 8 * (r >> 2);
        if (c < dl || c > dh) p0[r] = NEG;
        if (c + 32 < dl || c + 32 > dh) p1[r] = NEG; }
}
constexpr float ATT_THR = 6.f;
struct KvSrc { unsigned k[3], v[2]; };
__device__ __forceinline__ KvSrc kv_src(int wid, int lane) {
    KvSrc S;
#pragma unroll
    for (int i = 0; i < 3; ++i) { const int blk = wid * 3 + i, s = blk >> 3, r = 8 * (blk & 7) + (lane >> 3), c = (lane & 7) ^ ((r >> 1) & 7); S.k[i] = (unsigned)(r * 384 + (8 * s + c) * 16); }
#pragma unroll
    for (int i = 0; i < 2; ++i) { const int st = 2 * (wid * 2 + i) + (lane >> 5), kk = 8 * (st >> 2) + ((lane & 31) >> 2), k = (kk & ~0xC) | ((kk & 4) << 1) | ((kk & 8) >> 1), c = 32 * (st & 3) + 8 * (lane & 3);
        S.v[i] = (unsigned)(k * 256 + c * 2); }
    return S;
}
__device__ __forceinline__ void kv_dma_k(const KvSrc& S, LAS unsigned char* L, int koff, const bf16* __restrict__ Kg, int wid) {
    const GAS char* kg = (const GAS char*)Kg;
#pragma unroll
    for (int i = 0; i < 3; ++i) __builtin_amdgcn_global_load_lds((const GAS unsigned*)(kg + S.k[i]), (LAS unsigned*)(L + koff + (wid * 3 + i) * 1024), 16, 0, 0);
}
__device__ __forceinline__ void kv_dma_v(const KvSrc& S, LAS unsigned char* L, int voff, const bf16* __restrict__ Vg, int wid) {
    const GAS char* vg = (const GAS char*)Vg;
#pragma unroll
    for (int i = 0; i < 2; ++i) __builtin_amdgcn_global_load_lds((const GAS unsigned*)(vg + S.v[i]), (LAS unsigned*)(L + voff + (wid * 2 + i) * 1024), 16, 0, 0);
}
__device__ __forceinline__ void kv_dma(const KvSrc& S, LAS unsigned char* L, int koff, int voff, const bf16* __restrict__ Kg, const bf16* __restrict__ Vg, int wid) { kv_dma_k(S, L, koff, Kg, wid); kv_dma_v(S, L, voff, Vg, wid); }
__device__ __forceinline__ int next_tile(int j0, int jhi, unsigned bits) {
    if (j0 >= 32) return 32;
    const unsigned m = bits & (0xffffffffu << j0);
    const int j = m ? __builtin_ctz(m) : 32;
    return j < jhi ? j : 32;
}
#ifdef PROBE_ATT
#define ATT_PB0() const unsigned long long pb0_ = __builtin_amdgcn_s_memrealtime()
#define ATT_PB1() do { if (PROBE_ATT == 1) pr_att_acc += __builtin_amdgcn_s_memrealtime() - pb0_; } while (0)
#else
#define ATT_PB0()
#define ATT_PB1()
#endif
__device__ __forceinline__ float tile_rowmax(const f32x16& p0, const f32x16& p1) {
    float pmax = p0[0];
#pragma unroll
    for (int r = 1; r < 16; ++r) pmax = fmaxf(pmax, p0[r]);
#pragma unroll
    for (int r = 0; r < 16; ++r) pmax = fmaxf(pmax, p1[r]);
    return half_max(pmax);
}
__device__ __forceinline__ void attn_run(LAS unsigned char* L, const bf16* __restrict__ Kg, const bf16* __restrict__ Vg, int jlo, int jhi, unsigned tilebits,
                                         int klo, int khi, unsigned lanebits, const bf16x8 (&qf)[12], f32x16 (&o)[4], float& m_reg, float& l_reg, int tid, int wid, int lane, unsigned long long& pr_att_acc) {
    const int r32 = lane & 31, hi = lane >> 5;
    LAS float* al_l = (LAS float*)(L + ATT_WS + wid * 256);
    const unsigned vb0 = (unsigned)(size_t)(L + ATT_V) + (unsigned)v_rd_base(lane);
    int j = next_tile(jlo, jhi, tilebits);
    if (j >= 32) return;
    int lane_o = lane; asm volatile("" : "+v"(lane_o));
    const KvSrc S = kv_src(wid, lane_o);
    int jn = next_tile(j + 1, jhi, tilebits);
    __syncthreads();
    kv_dma(S, L, ATT_K, ATT_V, Kg + (size_t)j * 64 * DQK, Vg + (size_t)j * 64 * DVV, wid);
    if (jn < 32) kv_dma_k(S, L, ATT_K + 24576, Kg + (size_t)jn * 64 * DQK, wid);
    __syncthreads();
    f32x16 pA0, pA1, pB0, pB1;
    qkt(pA0, pA1, L + ATT_K, r32, hi, qf);
    { const bool lb = (lanebits >> (j & 31)) & 1u; if (!__all(lb && j * 64 >= klo && j * 64 + 63 <= khi)) mask_tile(pA0, pA1, j * 64, hi, klo, khi, lb); }
    __syncthreads();
#define ATT_STEP(PX0, PX1, PY0, PY1, PAR) { \
        const int jnn = jn < 32 ? next_tile(jn + 1, jhi, tilebits) : 32; \
        if (jnn < 32) kv_dma_k(S, L, ATT_K + (PAR) * 24576, Kg + (size_t)jnn * 64 * DQK, wid); \
        if (jn < 32) kv_dma_v(S, L, ATT_V + ((PAR) ^ 1) * 16384, Vg + (size_t)jn * 64 * DVV, wid); \
        const float pmax = tile_rowmax(PX0, PX1); float alpha = 1.f; \
        if (!__all(pmax - m_reg <= ATT_THR)) { const float mn = fmaxf(m_reg, pmax); alpha = fast_exp2(m_reg - mn); m_reg = mn; \
            if (__any(alpha < 1.f)) { _Pragma("unroll") for (int d = 0; d < 4; ++d) o[d] *= alpha; } } \
        SBAR(); \
        qkt(PY0, PY1, L + ATT_K + ((PAR) ^ 1) * 24576, r32, hi, qf);        \
        float ps = 0.f; \
        _Pragma("unroll") for (int r = 0; r < 16; ++r) { PX0[r] = fast_exp2(PX0[r] - m_reg); ps += PX0[r]; } \
        _Pragma("unroll") for (int r = 0; r < 16; ++r) { PX1[r] = fast_exp2(PX1[r] - m_reg); ps += PX1[r]; } \
        _Pragma("unroll") for (int g_ = 0; g_ < 24; ++g_) { __builtin_amdgcn_sched_group_barrier(0x008, 1, 0); __builtin_amdgcn_sched_group_barrier(0x100, 1, 0); __builtin_amdgcn_sched_group_barrier(0x002, 4, 0); } \
        SBAR(); \
        ps = half_sum(ps); l_reg = l_reg * alpha + ps; \
        bf16x8 pa0, pa1, pa2, pa3; pack_p(PX0, PX1, pa0, pa1, pa2, pa3); \
        pv_tile(o, vb0 + (unsigned)(PAR) * 16384u, pa0, pa1, pa2, pa3); \
        if (jn < 32) { const bool lb = (lanebits >> (jn & 31)) & 1u; if (!__all(lb && jn * 64 >= klo && jn * 64 + 63 <= khi)) mask_tile(PY0, PY1, jn * 64, hi, klo, khi, lb); } \
        ATT_PB0(); __syncthreads(); ATT_PB1(); \
        if (jn >= 32) break; \
        j = jn; jn = jnn; }
#ifdef PROBE_ATT
    const unsigned long long pl0_ = __builtin_amdgcn_s_memrealtime();
#endif
    for (;;) { ATT_STEP(pA0, pA1, pB0, pB1, 0) ATT_STEP(pB0, pB1, pA0, pA1, 1) }
#ifdef PROBE_ATT
    if (PROBE_ATT == 2) pr_att_acc += __builtin_amdgcn_s_memrealtime() - pl0_;
#endif
#undef ATT_STEP
}
__device__ __forceinline__ void attn_tile(LAS unsigned char* L, int koff, unsigned vb, int kb0, bool lb, int klo, int khi, const bf16x8 (&qf)[12], f32x16 (&o)[4], float& m_reg, float& l_reg,
                                          LAS float* al_l, int r32, int hi) {
    f32x16 p0, p1;
    qkt(p0, p1, L + koff, r32, hi, qf);
    const bool lane_full = lb && kb0 >= klo && kb0 + 63 <= khi, lane_none = !lb || kb0 > khi || kb0 + 63 < klo;
    const bool cut = !(lane_full || lane_none);
    float m_off = 0.f;
    if (__any(cut)) mask_tile(p0, p1, kb0, hi, klo, khi, lb);
    else m_off = lane_none ? __builtin_inff() : 0.f;
    float pmax = p0[0];
#pragma unroll
    for (int r = 1; r < 16; ++r) pmax = fmaxf(pmax, p0[r]);
#pragma unroll
    for (int r = 0; r < 16; ++r) pmax = fmaxf(pmax, p1[r]);
    pmax = half_max(pmax) - m_off;
    float alpha = 1.f;
    if (!__all(pmax - m_reg <= ATT_THR)) { const float mn = fmaxf(m_reg, pmax); alpha = fast_exp2(m_reg - mn); m_reg = mn; }
    const float me = m_reg + m_off;
    float ps = 0.f;
#pragma unroll
    for (int r = 0; r < 16; ++r) { p0[r] = fast_exp2(p0[r] - me); ps += p0[r]; }
#pragma unroll
    for (int r = 0; r < 16; ++r) { p1[r] = fast_exp2(p1[r] - me); ps += p1[r]; }
    ps = half_sum(ps);
    l_reg = l_reg * alpha + ps;
    if (__any(alpha < 1.f)) {
#pragma unroll
        for (int d = 0; d < 4; ++d) o[d] *= alpha; }
    bf16x8 pa0, pa1, pa2, pa3;
    pack_p(p0, p1, pa0, pa1, pa2, pa3);
    pv_tile(o, vb, pa0, pa1, pa2, pa3);
}
__device__ __forceinline__ void attn_run1(LAS unsigned char* L, const bf16* __restrict__ Kg, const bf16* __restrict__ Vg, int jlo, int jhi, unsigned tilebits,
                                         int klo, int khi, unsigned lanebits, const bf16x8 (&qf)[12], f32x16 (&o)[4], float& m_reg, float& l_reg, int tid, int wid, int lane) {
    const int r32 = lane & 31, hi = lane >> 5;
    LAS float* al_l = (LAS float*)(L + ATT_WS + wid * 256);
    const unsigned vb0 = (unsigned)(size_t)(L + ATT_V) + (unsigned)v_rd_base(lane);
    int j = next_tile(jlo, jhi, tilebits);
    if (j >= 32) return;
    int lane_o = lane; asm volatile("" : "+v"(lane_o));
    const KvSrc S = kv_src(wid, lane_o);
    __syncthreads();
    kv_dma(S, L, ATT_K, ATT_V, Kg + (size_t)j * 64 * DQK, Vg + (size_t)j * 64 * DVV, wid);
    __syncthreads();
#define ATT_STEP(CUR) { \
        const int jn = next_tile(j + 1, jhi, tilebits); const bool more = jn < 32; \
        if (more) kv_dma(S, L, ATT_K + ((CUR) ^ 1) * 24576, ATT_V + ((CUR) ^ 1) * 16384, Kg + (size_t)jn * 64 * DQK, Vg + (size_t)jn * 64 * DVV, wid); \
        const int kb0 = j * 64; \
        const bool lb = (lanebits >> (j & 31)) & 1u; \
        const bool lane_any = lb && kb0 <= khi && kb0 + 63 >= klo; \
        if (__any(lane_any)) attn_tile(L, ATT_K + (CUR) * 24576, vb0 + (unsigned)(CUR) * 16384u, kb0, lb, klo, khi, qf, o, m_reg, l_reg, al_l, r32, hi); \
        __syncthreads(); \
        if (!more) break; \
        j = jn; }
    for (;;) { ATT_STEP(0) ATT_STEP(1) }
#undef ATT_STEP
}
__device__ __forceinline__ void store_rows_bf16(const f32x16 (&v)[4], void* base, unsigned rowoff_bytes, int hi) {
    GAS char* bp = (GAS char*)base; const unsigned ro = rowoff_bytes + (hi ? 16u : 0u);
#pragma unroll
    for (int d0 = 0; d0 < 4; ++d0)
#pragma unroll
        for (int q4 = 0; q4 < 4; q4 += 2) {
            const unsigned ax = cvtpk(v[d0][4 * q4 + 0], v[d0][4 * q4 + 1]), ay = cvtpk(v[d0][4 * q4 + 2], v[d0][4 * q4 + 3]);
            const unsigned bx = cvtpk(v[d0][4 * q4 + 4], v[d0][4 * q4 + 5]), by = cvtpk(v[d0][4 * q4 + 6], v[d0][4 * q4 + 7]);
            auto r0 = __builtin_amdgcn_permlane32_swap(ax, bx, false, false); auto r1 = __builtin_amdgcn_permlane32_swap(ay, by, false, false);
            const v4u w = {r0[0], r1[0], r0[1], r1[1]};
            *(GAS v4u*)(bp + ro + (unsigned)((32 * d0 + 8 * q4) * 2)) = w; }
}
__device__ __forceinline__ void load_q(bf16x8 (&qf)[12], const bf16* Qbase, unsigned eoff, int hi) {
    const GAS char* qb = (const GAS char*)Qbase; const unsigned bo = (eoff + 8u * hi) * 2u;
#pragma unroll
    for (int ks = 0; ks < 12; ++ks) qf[ks] = *(const GAS bf16x8*)(qb + bo + 32u * ks);
}

__device__ __forceinline__ void mla_attn_phase(Frame& F, const bf16* QA, const bf16* KA, const bf16* VA, bf16* OA, unsigned long long& pr_acc) {
    LAS unsigned char* L = F.lds + RING_OFF; const int tid = F.tid, wid = F.wave, lane = F.lane, r32 = lane & 31, hi = lane >> 5;
    for (int item = F.vcu; item < 512; item += F.G) {
        const int bh = item >> 2, x = item & 3, b = bh >> 5, h = bh & 31;
        for (int pass = 0; pass < 2; ++pass) {
            const int qb = pass ? 7 - x : x;
            const int t = qb * 256 + wid * 32 + r32; const unsigned tok = (unsigned)b * SEQ + t;
            bf16x8 qf[12]; load_q(qf, QA, tok * UQ_N + h * DQK, hi);
            f32x16 o[4] = {}; float m_reg = -1e30f, l_reg = 0.f;
            attn_run(L, KA + (size_t)bh * SEQ * DQK, VA + (size_t)bh * SEQ * DVV, 0, 4 * qb + 4, 0xffffffffu, 0, t, 0xffffffffu, qf, o, m_reg, l_reg, tid, wid, lane, pr_acc);
            const float w = 1.f / l_reg;
#pragma unroll
            for (int d0 = 0; d0 < 4; ++d0) o[d0] *= w;
            unsigned e0 = (tok * DM + (unsigned)(h * DVV)) * 2u;
            asm volatile("" : "+v"(e0));
            store_rows_bf16(o, OA, e0, hi);
        }
    }
}
__device__ __forceinline__ f32x16 wave_gemm_tile(const bf16* __restrict__ Arow, const bf16* __restrict__ Wrow, int K, int hi) {
    f32x16 acc = {};
    const bf16* a = Arow + 8 * hi; const bf16* w = Wrow + 8 * hi;
#pragma unroll 16
    for (int k = 0; k < K; k += 16) { const bf16x8 av = *(const GAS bf16x8*)(a + k), wv = *(const GAS bf16x8*)(w + k); acc = __builtin_amdgcn_mfma_f32_32x32x16_bf16(av, wv, acc, 0, 0, 0); }
    return acc;
}
__device__ __forceinline__ void rope_cols_phase(Frame& F, const bf16* XN, const bf16* WA, float* UA) {
    const int lane = F.lane, r32 = lane & 31, hi = lane >> 5, wid = F.wave, tid = F.tid;
    LAS float* P = (LAS float*)(F.lds + RING_OFF);
    for (int rb = F.vcu; rb < M / 32; rb += F.G) {
        const bf16* A = XN + (size_t)(32 * rb + r32) * DM + wid * 512;
        const bf16* W0 = WA + wt_off(2048 + r32, wid * 512, DM); const bf16* W1 = W0 + 32 * 64;
        f32x16 a0 = {}, a1 = {};
#pragma unroll 8
        for (int k = 0; k < 512; k += 16) { const int ko = (k >> 6) * 16384 + (k & 63) + 8 * hi;
            const bf16x8 av = *(const GAS bf16x8*)(A + k + 8 * hi), w0 = *(const GAS bf16x8*)(W0 + ko), w1 = *(const GAS bf16x8*)(W1 + ko);
            a0 = __builtin_amdgcn_mfma_f32_32x32x16_bf16(av, w0, a0, 0, 0, 0); a1 = __builtin_amdgcn_mfma_f32_32x32x16_bf16(av, w1, a1, 0, 0, 0); }
        __syncthreads();
#pragma unroll
        for (int r = 0; r < 16; ++r) { P[(wid * 32 + crow(r, hi)) * 64 + r32] = a0[r]; P[(wid * 32 + crow(r, hi)) * 64 + 32 + r32] = a1[r]; }
        __syncthreads();
        { const int e0 = tid * 4, row = e0 >> 6, col = e0 & 63; f32x4 s = {0.f, 0.f, 0.f, 0.f};
#pragma unroll
          for (int w = 0; w < 8; ++w) s += *(const LAS f32x4*)(P + (w * 32 + row) * 64 + col);
          *(GAS f32x4*)(UA + (size_t)(32 * rb + row) * A_IN_PAD + 2048 + col) = s; }
    }
}
__device__ __forceinline__ void compress1_phase(Frame& F, const bf16* KB0, const bf16* VB0, const bf16* W1K, const bf16* W1V, const float* biasK, const float* biasV, bf16* HIDK, bf16* HIDV) {
    const int lane = F.lane, r32 = lane & 31, hi = lane >> 5, wid = F.wave, tid = F.tid;
    LAS float* P = (LAS float*)(F.lds + RING_OFF);
    for (int id = F.vcu; id < 384 + 256; id += F.G) {
        const bool isK = id < 384; const int i2 = isK ? id : id - 384; const int nn = isK ? 6 : 4;
        const int grp = i2 / (4 * nn), mt = (i2 / nn) & 3, nt = i2 % nn;
        const int dw = isK ? 192 : 128, K = 32 * dw, Ks = K / 8;
        const bf16* A = (isK ? KB0 : VB0) + ((size_t)grp * SEQ + 16 * (32 * mt + r32)) * dw + wid * Ks;
        const bf16* W = (isK ? W1K : W1V) + (size_t)(32 * nt + r32) * K + wid * Ks;
        const f32x16 acc = wave_gemm_tile(A, W, Ks, hi);
        __syncthreads();
#pragma unroll
        for (int r = 0; r < 16; ++r) P[(wid * 32 + crow(r, hi)) * 32 + r32] = acc[r];
        __syncthreads();
        { const int e0 = tid * 2, row = e0 >> 5, col = e0 & 31;
          float s0 = 0.f, s1 = 0.f;
#pragma unroll
          for (int w = 0; w < 8; ++w) { s0 += P[(w * 32 + row) * 32 + col]; s1 += P[(w * 32 + row) * 32 + col + 1]; }
          const int n = 32 * nt + col; const float* bias = isK ? biasK : biasV;
          bf16* H = (isK ? HIDK : HIDV) + (size_t)(grp * 128 + 32 * mt + row) * dw + n;
          *(GAS unsigned*)H = cvtpk(gelu_tanh(s0 + bias[n]), gelu_tanh(s1 + bias[n + 1])); }
    }
}
__device__ __forceinline__ void compress2_phase(Frame& F, const bf16* HIDK, const bf16* HIDV, const bf16* W2K, const bf16* W2V, bf16* KC, bf16* VC) {
    const int gw = F.vcu * NWAVES + F.wave, NGW = F.G * NWAVES, lane = F.lane, r32 = lane & 31, hi = lane >> 5;
    for (int id = gw; id < 384 + 256; id += NGW) {
        const bool isK = id < 384; const int i2 = isK ? id : id - 384; const int nn = isK ? 6 : 4;
        const int mt = i2 / nn, nt = i2 % nn;
        const int dw = isK ? 192 : 128;
        const bf16* A = (isK ? HIDK : HIDV) + (size_t)(32 * mt + r32) * dw;
        const bf16* W = (isK ? W2K : W2V) + (size_t)(32 * nt + r32) * dw;
        const f32x16 acc = wave_gemm_tile(A, W, dw, hi);
        bf16* O = (isK ? KC : VC) + (size_t)(32 * mt) * dw + 32 * nt + r32;
#pragma unroll
        for (int r = 0; r < 16; ++r) { const int row = 32 * mt + crow(r, hi); O[(size_t)crow(r, hi) * dw] = (row & 127) == 127 ? (bf16)0 : (bf16)f2bf(acc[r]); }
    }
}

__device__ __forceinline__ unsigned bfpair_add(unsigned acc, float a, float b) {
    const float lo = __builtin_bit_cast(float, acc << 16) + a, hi = __builtin_bit_cast(float, acc & 0xffff0000u) + b; return cvtpk(lo, hi); }
__device__ __forceinline__ void nsa_phase(Frame& F, const bf16* QB, const bf16* KC, const bf16* VC, const bf16* KB, const bf16* VB, const float* GATE, bf16* OB, unsigned* ACCS, unsigned* QCTR, unsigned long long& pr_acc) {
    LAS unsigned char* L = F.lds + RING_OFF; const int wid = F.wave;
    LAS float* IMP = (LAS float*)(L + ATT_IMP);
    LAS float* SC = (LAS float*)(L + ATT_SC);
    LAS unsigned* SELW = (LAS unsigned*)(L + ATT_SELW);
    LAS unsigned* QW = (LAS unsigned*)(L + ATT_SELW + 128);
#ifdef PROBE_NSA
#define NSA_T(k) do { const unsigned long long now_ = __builtin_amdgcn_s_memrealtime(); if (PROBE_NSA == (k) || PROBE_NSA == 9) pr_acc += now_ - pr_last; pr_last = now_; } while (0)
    unsigned long long pr_last = __builtin_amdgcn_s_memrealtime();
#else
#define NSA_T(k) do { } while (0)
#endif
    const int q0 = (int)((xb_xcc_id() >> 1) & 3u);
    for (int qi = 0; qi < 4; ++qi) { const int g = (q0 + qi) & 3;
    for (;;) {
        const int tid = fresh_tid(wid);
        const int lane = tid & 63, r32 = lane & 31, hi = lane >> 5;
        if (tid == 0) QW[0] = __hip_atomic_fetch_add(QCTR + 64 * g, 1u, __ATOMIC_RELAXED, __HIP_MEMORY_SCOPE_AGENT);
        __syncthreads();
        const int qidx = (int)QW[0];
        __syncthreads();
        if (qidx >= 256) break;
        NSA_T(0);
        const unsigned vb0 = (unsigned)(size_t)(L + ATT_V) + (unsigned)v_rd_base(lane);
        const int b = qidx & 3, ch = 63 - (qidx >> 2), t0 = ch * 32, t = t0 + r32;
        const unsigned tok = (unsigned)b * SEQ + t; const int head = g * HPG + wid;
        const unsigned goff = (tok * 96 + head * 3) * 4u;
        unsigned accp[4][8];
        const float gate0 = GOFF(const float, GATE, goff), gate1 = GOFF(const float, GATE, goff + 4u), gate2 = GOFF(const float, GATE, goff + 8u);
        unsigned aoff = (((unsigned)blockIdx.x * 8 + wid) * 64 + lane) * 128u;
        asm volatile("" : "+v"(aoff));
        {
            const bf16* Kg = KC + (size_t)(b * NG + g) * 128 * DQK; const bf16* Vg = VC + (size_t)(b * NG + g) * 128 * DVV;
            f32x16 pA0, pA1, pB0, pB1;
            { bf16x8 qc[12]; load_q(qc, QB, tok * UQ_N + head * DQK, hi);
              __syncthreads();
              { const KvSrc S = kv_src(wid, lane); kv_dma(S, L, ATT_K, ATT_V, Kg, Vg, wid); kv_dma(S, L, ATT_K2, ATT_V + 16384, Kg + 64 * DQK, Vg + 64 * DVV, wid); }
              if (tid < 32) SELW[tid] = 0u;
              __syncthreads();
              qkt(pA0, pA1, L + ATT_K, r32, hi, qc);
              qkt(pB0, pB1, L + ATT_K2, r32, hi, qc); }
            const int khi = t >= 31 ? ((t - 31) >> 4) : -1;
            mask_tile(pA0, pA1, 0, hi, 0, khi, true);
            mask_tile(pB0, pB1, 64, hi, 0, khi, true);
            float mx = -__builtin_inff();
#pragma unroll
            for (int r = 0; r < 16; ++r) mx = fmaxf(fmaxf(mx, pA0[r]), fmaxf(pA1[r], fmaxf(pB0[r], pB1[r])));
            mx = half_max(mx);
            const float ms = (mx == -__builtin_inff()) ? 0.f : mx;
            float ps = 0.f;
#pragma unroll
            for (int r = 0; r < 16; ++r) { pA0[r] = fast_exp2(pA0[r] - ms); pA1[r] = fast_exp2(pA1[r] - ms); pB0[r] = fast_exp2(pB0[r] - ms); pB1[r] = fast_exp2(pB1[r] - ms); ps += (pA0[r] + pA1[r]) + (pB0[r] + pB1[r]); }
            ps = half_sum(ps);
            const float inv = ps > 0.f ? 1.f / ps : 0.f;
#pragma unroll
            for (int r = 0; r < 16; ++r) { pA0[r] *= inv; pA1[r] *= inv; pB0[r] *= inv; pB1[r] *= inv; }
            LAS float* imp = IMP + (wid * 32 + r32) * 32;
#define IMP_MAIN(P, base) do { _Pragma("unroll") for (int q4 = 0; q4 < 4; ++q4) imp[(base) + hi + 2 * q4] = (P[4 * q4] + P[4 * q4 + 1]) + (P[4 * q4 + 2] + P[4 * q4 + 3]); } while (0)
            IMP_MAIN(pA0, 0); IMP_MAIN(pA1, 8); IMP_MAIN(pB0, 16); IMP_MAIN(pB1, 24);
            asm volatile("s_waitcnt lgkmcnt(0)" ::: "memory");
#define IMP_EXTRA(P, base) do { _Pragma("unroll") for (int q4 = 0; q4 < 4; ++q4) { const int J1 = (base) + hi + 2 * q4 + 1; if (J1 < 32) imp[J1] += P[4 * q4 + 3]; } } while (0)
            IMP_EXTRA(pA0, 0); IMP_EXTRA(pA1, 8); IMP_EXTRA(pB0, 16); IMP_EXTRA(pB1, 24);
#undef IMP_MAIN
#undef IMP_EXTRA
            f32x16 o[4] = {}; bf16x8 pa0, pa1, pa2, pa3;
            pack_p(pA0, pA1, pa0, pa1, pa2, pa3); pv_tile(o, vb0, pa0, pa1, pa2, pa3);
            pack_p(pB0, pB1, pa0, pa1, pa2, pa3); pv_tile(o, vb0 + 16384u, pa0, pa1, pa2, pa3);
#pragma unroll
            for (int d0 = 0; d0 < 4; ++d0)
#pragma unroll
                for (int i = 0; i < 8; ++i) accp[d0][i] = cvtpk(o[d0][2 * i] * gate0, o[d0][2 * i + 1] * gate0);
        }
        NSA_T(1);
        __syncthreads();
        { const int tid2 = fresh_tid(wid); const int tk = tid2 >> 4, jj = tid2 & 15, tt = t0 + tk, cur = tt >> 6;
#pragma unroll
          for (int e = 0; e < 2; ++e) { const int j = jj + 16 * e; float s = 0.f;
#pragma unroll
              for (int w = 0; w < 8; ++w) s += IMP[(w * 32 + tk) * 32 + j];
              const bool valid = j <= cur, forced = valid && (j == 0 || j == cur || j == cur - 1);
              SC[tk * 32 + j] = valid ? s + (forced ? 1e4f : 0.f) : -__builtin_inff(); }
          __syncthreads();
          unsigned bits = 0u;
#pragma unroll
          for (int e = 0; e < 2; ++e) { const int j = jj + 16 * e; const float sj = SC[tk * 32 + j]; int rank = 0;
              for (int j2 = 0; j2 < 32; ++j2) { const float s2 = SC[tk * 32 + j2]; rank += (s2 > sj || (s2 == sj && j2 < j)) ? 1 : 0; }
              if (j <= cur && rank < 16) bits |= 1u << j; }
          if (bits) __hip_atomic_fetch_or(&SELW[tk], bits, __ATOMIC_RELAXED, __HIP_MEMORY_SCOPE_WORKGROUP);
          __syncthreads(); }
        NSA_T(2);
        const unsigned sel = SELW[r32];
        unsigned un = sel;
        un |= swz_xor_u<1>(un); un |= swz_xor_u<2>(un); un |= swz_xor_u<4>(un); un |= swz_xor_u<8>(un); un |= swz_xor_u<16>(un);
        un = __builtin_amdgcn_readfirstlane(un);
        const size_t slab = (size_t)(b * NG + g) * SEQ;
        const int jhi = ((t0 + 31) >> 6) + 1;
        const int wlo = t0 - 511 > 0 ? t0 - 511 : 0, wklo = t - 511 > 0 ? t - 511 : 0;
        for (int br = 1; br <= 2; ++br) {
            const bool isw = br == 2;
            unsigned qoff = tok * UQ_N + head * DQK; asm volatile("" : "+v"(qoff));
            bf16x8 qf[12]; load_q(qf, QB, qoff, hi);
            f32x16 o[4] = {}; float m_reg = -1e30f, l_reg = 0.f;
            attn_run1(L, KB + (size_t)br * KB_BR + slab * DQK, VB + (size_t)br * VB_BR + slab * DVV, isw ? (wlo >> 6) : 0, jhi, isw ? 0xffffffffu : un, isw ? wklo : 0, t, isw ? 0xffffffffu : sel, qf, o, m_reg, l_reg, tid, wid, lane);
            NSA_T(2 + br);
            const float wgt = (isw ? gate2 : gate1) / l_reg;
            if (!isw) {
#pragma unroll
                for (int d0 = 0; d0 < 4; ++d0)
#pragma unroll
                    for (int i = 0; i < 8; ++i) accp[d0][i] = bfpair_add(accp[d0][i], o[d0][2 * i] * wgt, o[d0][2 * i + 1] * wgt);
            } else {
#pragma unroll
                for (int d0 = 0; d0 < 4; ++d0)
#pragma unroll
                    for (int i = 0; i < 8; ++i) { o[d0][2 * i] = __builtin_bit_cast(float, accp[d0][i] << 16) + o[d0][2 * i] * wgt; o[d0][2 * i + 1] = __builtin_bit_cast(float, accp[d0][i] & 0xffff0000u) + o[d0][2 * i + 1] * wgt; }
                unsigned e0 = (tok * DM + (unsigned)(head * DVV)) * 2u;
                asm volatile("" : "+v"(e0));
                store_rows_bf16(o, OB, e0, hi);
            }
            NSA_T(5);
        }
    }
    }
}
constexpr int N_PHASES = 20;
struct Args { const float* in[24]; float* out; unsigned char* ws; int ph_lo, ph_hi; };
__global__ void __launch_bounds__(NWAVES * 64, 2) yoco_fwd(Args args) {
    extern __shared__ __attribute__((aligned(16))) unsigned char lds[];
    Frame F;
    F.lds = (LAS unsigned char*)lds;
    F.MISC = (volatile LAS unsigned*)(F.lds + MISC_OFF);
    F.tid = threadIdx.x; F.lane = F.tid & 63; F.wave = __builtin_amdgcn_readfirstlane(F.tid >> 6);
    F.G = gridDim.x; { const int bx = blockIdx.x; F.vcu = (F.G % 8 == 0) ? (bx % 8) * (F.G / 8) + bx / 8 : bx; }
    unsigned char* ws = args.ws; F.ws = ws;
    F.ctl = (gu32*)(ws + WS_CTL);
    for (int u = F.tid; u < (LDS_BYTES - LDSCTL_OFF) / 4; u += NWAVES * 64) ((LAS unsigned*)(F.lds + LDSCTL_OFF))[u] = 0u;
    __syncthreads();
    XcdBarrier bar = xcd_barrier_post((unsigned*)(F.ctl + CW_BAR), F.MISC + 8);
    frame_fresh(F);
    const int lo = args.ph_lo, hi = args.ph_hi;
    unsigned long long pr_nsa = 0;
#ifdef PROBE_TS
    unsigned long long pr_t0 = __builtin_amdgcn_s_memrealtime(), pr_t1 = 0, pr_c0 = 0, pr_c1 = 0;
#endif
#ifndef PH_MASK
#define PH_MASK 0xFFFFFu
#endif
#define IN(k) (((PH_MASK >> (k)) & 1u) && lo <= (k) && (k) < hi)
#ifndef REP_MASK
#define REP_MASK 0u
#endif
#define REP(k) for (int rep_ = 0; rep_ < ((((unsigned)REP_MASK >> (k)) & 1u) ? 2 : 1); ++rep_)
#define INR(k) (lo <= (k) && (k) < hi)
#ifdef PROBE_TS
#define SEAM(k) do { if ((k) == PROBE_TS - 1) { pr_c0 = __builtin_amdgcn_s_memtime(); pr_t0 = (PROBE_CLK ? __builtin_amdgcn_s_memrealtime() : pr_t0); } if (INR(k) && INR((k) + 1)) xcd_barrier(bar); if ((k) == PROBE_TS) { pr_t1 = __builtin_amdgcn_s_memrealtime(); pr_c1 = __builtin_amdgcn_s_memtime(); } } while (0)
#else
#define SEAM(k) do { if (INR(k) && INR((k) + 1)) xcd_barrier(bar); } while (0)
#endif

    LAS unsigned char* RING = F.lds + RING_OFF;
    const int bid = (int)blockIdx.x;

    REP(0) if (IN(0)) {
        frame_fresh(F);
        for (int l = 1; l >= 0; --l) {
            if (l == 0) {
                conv_colmax(F, args.in[19], DM, DM, nullptr, F.ctl + CW_CMAX + CM_WOB, 0, MapId{});
                conv_colmax(F, args.in[10], DM, 3840, args.in[9], F.ctl + CW_CMAX, 0, InvSkv{});
                conv_colmax(F, args.in[18], DM, 6240, args.in[17], F.ctl + CW_CMAX, 3840, InvBin{});
            }
            conv_fast(F, args.in[22] + (size_t)l * FF * DM, FF, DM, nullptr, (bf16*)(ws + WS_WFO + l * WFO_STRIDE), 0, MapId{});
            if (ffn_q8(l)) conv_colmax(F, args.in[21] + (size_t)l * DM * 2 * FF, DM, 2 * FF, args.in[20] + (size_t)l * DM, F.ctl + CW_CMAX + (l ? CM_FFI : CM_FFI0), 0, InvFfi{});
            else conv_fast(F, args.in[21] + (size_t)l * DM * 2 * FF, DM, 2 * FF, args.in[20] + (size_t)l * DM, (bf16*)(ws + WS_WFI + l * WFI_STRIDE), 0, InvFfi{});
        }
        conv_colmax(F, args.in[8], DM, DM, nullptr, F.ctl + CW_CMAX + CM_WOA, 0, MapId{});
        conv_colmax(F, args.in[7], KVL, UKV_N, args.in[6], F.ctl + CW_CMAX + CM_WUKV, 0, MapId{});
        conv_colmax(F, args.in[5], QL, UQ_N, args.in[4], F.ctl + CW_CMAX + CM_WUQ, 0, InvUq{});
        conv_fast(F, args.in[3], DM, A_IN, args.in[2], (bf16*)(ws + WS_WA), 0, MapId{});
        zero_rows(F, (bf16*)(ws + WS_WA), DM, A_IN, A_IN_PAD);
        conv_matrix(F, args.in[12], 192, nullptr, (bf16*)(ws + WS_W1K), 6144, 192, 0, MapId{}, MapW1kRow{});
        conv_matrix(F, args.in[13], 192, nullptr, (bf16*)(ws + WS_W2K), 192, 192, 0, MapW2kCol{}, MapId{});
        conv_matrix(F, args.in[15], 128, nullptr, (bf16*)(ws + WS_W1V), 4096, 128, 0, MapId{}, MapId{});
        conv_matrix(F, args.in[16], 128, nullptr, (bf16*)(ws + WS_W2V), 128, 128, 0, MapId{}, MapId{});
        rope_tables(F, (const int*)args.in[1], (f32x2*)(ws + WS_TABA), (f32x2*)(ws + WS_TABB));
        pe_bias(F, args.in[11], args.in[12], 6144, 192, (float*)(ws + WS_BIAS));
        pe_bias(F, args.in[14], args.in[15], 4096, 128, (float*)(ws + WS_BIAS) + 256);
        norm_phase(F, args.in[0], (bf16*)(ws + WS_XN));
    }
    SEAM(0);
    REP(1) if (IN(1)) { pg8::Gemm g{(const bf16*)(ws + WS_XN), (const bf16*)(ws + WS_WA), M, 2048, DM}; pg8::StaticOrder S; S.init(M, 2048, F.G, bid);
        EpiRow8<FnUA> E{FnUA{(float*)(ws + WS_UA)}}; pg8::gemm_phase<EpiRow8<FnUA>, pg8::StaticOrder, true, true, false, true>(RING, g, S, E, F.wave);
        frame_fresh(F); rope_cols_phase(F, (const bf16*)(ws + WS_XN), (const bf16*)(ws + WS_WA), (float*)(ws + WS_UA)); }
    SEAM(1);
    REP(2) if (IN(2)) { frame_fresh(F); conv_fast_q8(F, args.in[8], DM, DM, nullptr, (signed char*)(ws + WS_WOA), F.ctl + CW_CMAX + CM_WOA, 0, MapId{});
        conv_fast_q8(F, args.in[5], QL, UQ_N, args.in[4], (signed char*)(ws + WS_WUQ), F.ctl + CW_CMAX + CM_WUQ, 0, InvUq{});
        conv_fast_q8(F, args.in[7], KVL, UKV_N, args.in[6], (signed char*)(ws + WS_WUKV), F.ctl + CW_CMAX + CM_WUKV, 0, MapId{});
        mla_latent_phase(F, (const float*)(ws + WS_UA), (signed char*)(ws + WS_CQ), (signed char*)(ws + WS_CKV), (float*)(ws + WS_SA) + 8192, (float*)(ws + WS_SA) + 16384, (bf16*)(ws + WS_KA), (const f32x2*)(ws + WS_TABA)); }
    SEAM(2);
    REP(3) if (IN(3)) {
        { pg8::Gemm g{(const bf16*)(ws + WS_CQ), (const bf16*)(ws + WS_WUQ), M, UQ_N, QL / 2}; pg8::StaticOrder S; S.init(M, UQ_N, F.G, bid);
          EpiI8<EpiRow8<FnQa>> E{EpiRow8<FnQa>{FnQa{(bf16*)(ws + WS_QA), (const f32x2*)(ws + WS_TABA)}}, (const float*)(ws + WS_SA) + 8192, F.ctl + CW_CMAX + CM_WUQ};
          pg8::gemm_phase<EpiI8<EpiRow8<FnQa>>, pg8::StaticOrder, true, true, false, true, true>(RING, g, S, E, F.wave); }
        __syncthreads();
        { pg8::Gemm g{(const bf16*)(ws + WS_CKV), (const bf16*)(ws + WS_WUKV), M, UKV_N, KVL / 2}; pg8::StaticOrder S; S.init(M, UKV_N, F.G, bid);
          EpiI8<EpiRow8<FnKVa>> E{EpiRow8<FnKVa>{FnKVa{(bf16*)(ws + WS_KA), (bf16*)(ws + WS_VA)}}, (const float*)(ws + WS_SA) + 16384, F.ctl + CW_CMAX + CM_WUKV};
          pg8::gemm_phase<EpiI8<EpiRow8<FnKVa>>, pg8::StaticOrder, true, true, false, true, true>(RING, g, S, E, F.wave); }
    }
    SEAM(3);
    REP(4) if (IN(4)) { frame_fresh(F); mla_attn_phase(F, (const bf16*)(ws + WS_QA), (const bf16*)(ws + WS_KA), (const bf16*)(ws + WS_VA), (bf16*)(ws + WS_OA), pr_nsa); }
    SEAM(4);
    if (IN(5)) { frame_fresh(F); quant_rows_phase(F, (const bf16*)(ws + WS_OA), (signed char*)(ws + WS_XN8), (float*)(ws + WS_SA)); xcd_barrier(bar); }
    REP(5) if (IN(5)) { pg8::Gemm g{(const bf16*)(ws + WS_XN8), (const bf16*)(ws + WS_WOA), M, DM, DM / 2}; pg8::StaticOrder S; S.init(M, DM, F.G, bid);
        EpiI8<EpiRow8<FnResNew>> E{EpiRow8<FnResNew>{FnResNew{args.in[0], (float*)(ws + WS_H)}}, (const float*)(ws + WS_SA), F.ctl + CW_CMAX + CM_WOA};
        pg8::gemm_phase<EpiI8<EpiRow8<FnResNew>>, pg8::StaticOrder, true, true, false, true, true>(RING, g, S, E, F.wave); }
    SEAM(5);
#define FFN_PHASES(layer, pb, HIN, HOUT) do { \
        REP((pb) + 6) if (IN((pb) + 6)) { frame_fresh(F); \
            if (ffn_q8(layer)) { norm_phase_q8(F, (const float*)(ws + HIN), (signed char*)(ws + WS_XN8), (float*)(ws + WS_SA)); \
                conv_fast_q8(F, args.in[21] + (size_t)(layer) * DM * 2 * FF, DM, 2 * FF, args.in[20] + (size_t)(layer) * DM, (signed char*)(ws + WS_WFI + (layer) * WFI_STRIDE), F.ctl + CW_CMAX + ((layer) ? CM_FFI : CM_FFI0), 0, InvFfi{}); } \
            else norm_phase(F, (const float*)(ws + HIN), (bf16*)(ws + WS_XN)); } \
        SEAM((pb) + 6); \
        REP((pb) + 7) if (IN((pb) + 7)) { \
            if (ffn_q8(layer)) { pg8::Gemm g{(const bf16*)(ws + WS_XN8), (const bf16*)(ws + WS_WFI + (layer) * WFI_STRIDE), M, 2 * FF, DM / 2}; pg8::StaticOrder S; S.init(M, 2 * FF, F.G, bid); \
                EpiI8<EpiGate<FnSwiglu>> E{EpiGate<FnSwiglu>{FnSwiglu{(bf16*)(ws + WS_ACT)}}, (const float*)(ws + WS_SA), F.ctl + CW_CMAX + ((layer) ? CM_FFI : CM_FFI0)}; \
                pg8::gemm_phase<EpiI8<EpiGate<FnSwiglu>>, pg8::StaticOrder, true, true, false, true, true>(RING, g, S, E, F.wave); } \
            else { pg8::Gemm g{(const bf16*)(ws + WS_XN), (const bf16*)(ws + WS_WFI + (layer) * WFI_STRIDE), M, 2 * FF, DM}; pg8::StaticOrder S; S.init(M, 2 * FF, F.G, bid); \
                EpiGate<FnSwiglu> E{FnSwiglu{(bf16*)(ws + WS_ACT)}}; pg8::gemm_phase<EpiGate<FnSwiglu>, pg8::StaticOrder, true, true, false, true>(RING, g, S, E, F.wave); } } \
        SEAM((pb) + 7); \
        REP((pb) + 8) if (IN((pb) + 8)) { pg8::Gemm g{(const bf16*)(ws + WS_ACT), (const bf16*)(ws + WS_WFO + (layer) * WFO_STRIDE), M, DM, FF}; pg8::StaticOrder S; S.init(M, DM, F.G, bid); \
            EpiRow8<FnResNew> E{FnResNew{(const float*)(ws + HIN), (float*)(ws + HOUT)}}; pg8::gemm_phase<EpiRow8<FnResNew>, pg8::StaticOrder, true, true, true, true>(RING, g, S, E, F.wave); } \
        SEAM((pb) + 8); } while (0)
    FFN_PHASES(0, 0, WS_H, WS_H2);
    REP(9) if (IN(9)) { frame_fresh(F); norm_phase_q8(F, (const float*)(ws + WS_H2), (signed char*)(ws + WS_XN8), (float*)(ws + WS_SA));
        conv_fast_q8(F, args.in[10], DM, 3840, args.in[9], (signed char*)(ws + WS_WSB), F.ctl + CW_CMAX, 0, InvSkv{});
        conv_fast_q8(F, args.in[18], DM, 6240, args.in[17], (signed char*)(ws + WS_WSB), F.ctl + CW_CMAX, 3840, InvBin{});
        zero_rows8(F, (signed char*)(ws + WS_WSB), DM, 3840 + 6240, SB_N);
        conv_fast_q8(F, args.in[19], DM, DM, nullptr, (signed char*)(ws + WS_WOB), F.ctl + CW_CMAX + CM_WOB, 0, MapId{}); }
    SEAM(9);
    REP(10) if (IN(10)) { pg8::Gemm g{(const bf16*)(ws + WS_XN8), (const bf16*)(ws + WS_WSB), M, SB_N, DM / 2}; pg8::StaticOrder S; S.init(M, SB_N, F.G, bid);
        EpiI8<EpiSB> E{EpiSB{(bf16*)(ws + WS_KB), (bf16*)(ws + WS_VB), (bf16*)(ws + WS_QA), (float*)(ws + WS_GATE), (const f32x2*)(ws + WS_TABB)}, (const float*)(ws + WS_SA), F.ctl + CW_CMAX};
        pg8::gemm_phase<EpiI8<EpiSB>, pg8::StaticOrder, true, true, false, true, true>(RING, g, S, E, F.wave); }
    SEAM(10);
    REP(11) if (IN(11)) { frame_fresh(F); compress1_phase(F, (const bf16*)(ws + WS_KB), (const bf16*)(ws + WS_VB), (const bf16*)(ws + WS_W1K), (const bf16*)(ws + WS_W1V), (const float*)(ws + WS_BIAS), (const float*)(ws + WS_BIAS) + 256, (bf16*)(ws + WS_HIDK), (bf16*)(ws + WS_HIDV)); }
    SEAM(11);
    REP(12) if (IN(12)) { frame_fresh(F); compress2_phase(F, (const bf16*)(ws + WS_HIDK), (const bf16*)(ws + WS_HIDV), (const bf16*)(ws + WS_W2K), (const bf16*)(ws + WS_W2V), (bf16*)(ws + WS_KC), (bf16*)(ws + WS_VC)); }
    SEAM(12);
    REP(13) if (IN(13)) { frame_fresh(F); nsa_phase(F, (const bf16*)(ws + WS_QA), (const bf16*)(ws + WS_KC), (const bf16*)(ws + WS_VC), (const bf16*)(ws + WS_KB), (const bf16*)(ws + WS_VB), (const float*)(ws + WS_GATE), (bf16*)(ws + WS_OA), (unsigned*)(ws + WS_OC), (unsigned*)(F.ctl + CW_NSAQ), pr_nsa); }
    SEAM(13);
    if (IN(14)) { frame_fresh(F); quant_rows_phase(F, (const bf16*)(ws + WS_OA), (signed char*)(ws + WS_XN8), (float*)(ws + WS_SA)); }
    SEAM(14);
    REP(15) if (IN(15)) { pg8::Gemm g{(const bf16*)(ws + WS_XN8), (const bf16*)(ws + WS_WOB), M, DM, DM / 2}; pg8::StaticOrder S; S.init(M, DM, F.G, bid);
        EpiI8<EpiRow8<FnResNew>> E{EpiRow8<FnResNew>{FnResNew{(const float*)(ws + WS_H2), (float*)(ws + WS_H)}}, (const float*)(ws + WS_SA), F.ctl + CW_CMAX + CM_WOB};
        pg8::gemm_phase<EpiI8<EpiRow8<FnResNew>>, pg8::StaticOrder, true, true, false, true, true>(RING, g, S, E, F.wave); }
    SEAM(15);
    FFN_PHASES(1, 10, WS_H, WS_H2);
    REP(19) if (IN(19)) { frame_fresh(F); final_norm_phase(F, (const float*)(ws + WS_H2), args.in[23], args.out); }
#undef FFN_PHASES
#if defined(PROBE_NSA) || defined(PROBE_ATT)
    if (blockIdx.x == PROBE_BLK) { const unsigned long long wait = 4ull * pr_nsa; const unsigned long long s0 = __builtin_amdgcn_s_memrealtime(); while (__builtin_amdgcn_s_memrealtime() - s0 < wait) __builtin_amdgcn_s_sleep(8); }
#endif
#ifdef PROBE_TS
    if (blockIdx.x == 0) { unsigned long long wait = PROBE_CLK ? (pr_c1 - pr_c0) * 100ull / ((pr_t1 - pr_t0) + 1ull) * 100ull : 4ull * (pr_t1 - pr_t0);
        const unsigned long long s0 = __builtin_amdgcn_s_memrealtime(); while (__builtin_amdgcn_s_memrealtime() - s0 < wait) __builtin_amdgcn_s_sleep(8); }
#endif
#undef IN
#undef INR
#undef SEAM
}

extern "C" void kernel_launch(void* const* d_in, const int* in_sizes, int n_in, void* d_out, int out_size, void* d_ws, size_t ws_size, hipStream_t stream) {
    static int grid = 0;
    if (grid == 0) {
        if (n_in != 24 || out_size != M * DM || ws_size < WS_END) { fprintf(stderr, "kernel_launch: unexpected shapes (n_in %d out %d ws %zu need %zu)\n", n_in, out_size, ws_size, (size_t)WS_END); grid = -1; return; }
        int dev = 0, cus = 0, per_cu = 0;
        if (hipGetDevice(&dev) != hipSuccess || hipDeviceGetAttribute(&cus, hipDeviceAttributeMultiprocessorCount, dev) != hipSuccess) { grid = -1; return; }
        if (hipFuncSetAttribute((const void*)yoco_fwd, hipFuncAttributeMaxDynamicSharedMemorySize, LDS_BYTES) != hipSuccess) { fprintf(stderr, "kernel_launch: hipFuncSetAttribute failed\n"); grid = -1; return; }
        if (hipOccupancyMaxActiveBlocksPerMultiprocessor(&per_cu, (const void*)yoco_fwd, NWAVES * 64, LDS_BYTES) != hipSuccess || per_cu < 1)
            fprintf(stderr, "kernel_launch: occupancy query reports %d workgroups per CU\n", per_cu);
        (void)hipGetLastError();
        grid = cus;
    }
    if (grid < 0) return;
    if (hipMemsetAsync((char*)d_ws + WS_CTL, 0, CTL_ZERO_BYTES, stream) != hipSuccess) return;
    Args a{};
    for (int i = 0; i < 24; ++i) a.in[i] = (const float*)d_in[i];
    a.out = (float*)d_out; a.ws = (unsigned char*)d_ws;
#if MK_ONE_LAUNCH
    a.ph_lo = 0; a.ph_hi = N_PHASES;
    hipLaunchKernelGGL(yoco_fwd, dim3(grid), dim3(NWAVES * 64), LDS_BYTES, stream, a);
#else
    for (int p = 0; p < N_PHASES; ++p) { a.ph_lo = p; a.ph_hi = p + 1; hipLaunchKernelGGL(yoco_fwd, dim3(grid), dim3(NWAVES * 64), LDS_BYTES, stream, a); }
#endif
}
```
